# Optimizing an MI355X kernel written in HIP

```python
import math
import jax, jax.numpy as jnp
from jax import lax
import numpy as np

D_MODEL = 1024
BATCH = 32
SEQ = 2048
DEPTH = 2

CHUNK = 64
Q_BLOCK = 128
EPS = 1e-6
MASK_VALUE = -1e30
TINY = 1e-30
H_A = 4
DK_A = D_MODEL // 16
DV_A = 2 * DK_A
ROT_DIM = DK_A // 4
ROPE_THETA = 500000.0
H_B = 4
DK_B = D_MODEL // 16
DV_B = D_MODEL // 16
C_WIDTH = D_MODEL // 4
CONV_WIDTH = 3
D_MIX = H_A * DV_A + H_B * DV_B + C_WIDTH
SPLIT_SIZES = (H_A * 2 * DK_A, H_A * 2 * DK_A, H_A * DV_A,
               H_B * DK_B, H_B * DK_B, H_B * DV_B, H_B * DV_B,
               C_WIDTH, C_WIDTH, C_WIDTH)
D_IN = H_A * (4 * DK_A + DV_A) + H_B * (2 * DK_B + 2 * DV_B) + 3 * C_WIDTH
N_GROUPS = 4
EXPERTS_PER_GROUP = 8
N_EXPERTS = N_GROUPS * EXPERTS_PER_GROUP
TOP_K_INNER = 2
D_EXPERT = D_MODEL // 2
MOE_BLOCK = 256

kernel_name = "hymba_style_hybrid_diffattn_hgrn2_shortconv_hmoe"


def rms_norm(x, g):
    xf = x.astype(jnp.float32)
    y = xf * lax.rsqrt(jnp.mean(xf * xf, axis=-1, keepdims=True) + EPS)
    return (y * g.astype(jnp.float32)).astype(x.dtype)


def partial_rope(t, cos, sin):
    half = ROT_DIM // 2
    tf = t.astype(jnp.float32)
    t1, t2, rest = tf[..., :half], tf[..., half:ROT_DIM], tf[..., ROT_DIM:]
    out = jnp.concatenate([t1 * cos - t2 * sin, t1 * sin + t2 * cos, rest], axis=-1)
    return out.astype(t.dtype)


def differential_attention(q_in, k_in, v_in, positions, q_g, k_g, lq1, lk1, lq2, lk2, subln_g, layer_idx):
    b, s = q_in.shape[0], q_in.shape[1]
    q = rms_norm(q_in.reshape(b, s, H_A, 2, DK_A), q_g)
    k = rms_norm(k_in.reshape(b, s, H_A, 2, DK_A), k_g)
    v = v_in.reshape(b, s, H_A, DV_A)
    inv_freq = ROPE_THETA ** (-jnp.arange(0, ROT_DIM, 2, dtype=jnp.float32) / ROT_DIM)
    ang = positions.astype(jnp.float32)[..., None] * inv_freq
    cos = jnp.cos(ang)[:, :, None, None, :]
    sin = jnp.sin(ang)[:, :, None, None, :]
    q = partial_rope(q, cos, sin)
    k = partial_rope(k, cos, sin)
    lam_init = 0.8 - 0.6 * math.exp(-0.3 * layer_idx)
    lam = (jnp.exp(jnp.sum(lq1.astype(jnp.float32) * lk1.astype(jnp.float32)))
           - jnp.exp(jnp.sum(lq2.astype(jnp.float32) * lk2.astype(jnp.float32))) + lam_init)
    scale = DK_A ** -0.5
    pos_chunk = jnp.arange(s) // CHUNK
    outs = []
    for blk in range(s // Q_BLOCK):
        q_lo, q_hi = blk * Q_BLOCK, (blk + 1) * Q_BLOCK
        scores = jnp.einsum('bqhcd,bkhcd->bhcqk', q[:, q_lo:q_hi], k[:, :q_hi]).astype(jnp.float32) * scale
        mask = pos_chunk[None, :q_hi] <= pos_chunk[q_lo:q_hi, None]
        probs = jax.nn.softmax(jnp.where(mask, scores, MASK_VALUE), axis=-1)
        weights = probs[:, :, 0] - lam * probs[:, :, 1]
        outs.append(jnp.einsum('bhqk,bkhv->bqhv', weights.astype(v.dtype), v[:, :q_hi]))
    o = jnp.concatenate(outs, axis=1)
    o = rms_norm(o, subln_g) * (1.0 - lam_init)
    return o.reshape(b, s, H_A * DV_A)


def hgrn2(q_in, f_in, i_in, g_in, lb, norm_g):
    b, s = q_in.shape[0], q_in.shape[1]
    nc = s // CHUNK
    zf = f_in.reshape(b, s, H_B, DK_B).astype(jnp.float32)
    lbh = lb.reshape(H_B, DK_B).astype(jnp.float32)
    f = lbh + (1.0 - lbh) * jax.nn.sigmoid(zf)
    log_f = jnp.log(jnp.maximum(f, TINY))
    key = (1.0 - lbh) * jax.nn.sigmoid(-zf)
    q = jax.nn.silu(q_in.reshape(b, s, H_B, DK_B).astype(jnp.float32))
    v = i_in.reshape(b, s, H_B, DV_B).astype(jnp.float32)

    def to_chunks(t):
        return t.reshape(b, nc, CHUNK, H_B, t.shape[-1]).transpose(1, 0, 3, 2, 4)

    tri = (jnp.arange(CHUNK)[:, None] >= jnp.arange(CHUNK)[None, :])[:, :, None]

    def step(state, inp):
        qc, kc, vc, lfc = inp
        g = jnp.cumsum(lfc, axis=2)
        diff = g[:, :, :, None, :] - g[:, :, None, :, :]
        decay = jnp.where(tri, jnp.exp(jnp.where(tri, diff, 0.0)), 0.0)
        scores = jnp.einsum('bhtd,bhsd,bhtsd->bhts', qc, kc, decay)
        o = (jnp.einsum('bhts,bhsv->bhtv', scores, vc)
             + jnp.einsum('bhtd,bhdv->bhtv', qc * jnp.exp(g), state))
        g_last = g[:, :, -1:, :]
        new_state = (jnp.exp(g_last[:, :, 0, :])[..., None] * state
                     + jnp.einsum('bhsd,bhsv->bhdv', kc * jnp.exp(g_last - g), vc))
        return new_state, o

    state0 = jnp.zeros((b, H_B, DK_B, DV_B), jnp.float32)
    _, o = lax.scan(step, state0, (to_chunks(q), to_chunks(key), to_chunks(v), to_chunks(log_f)))
    o = o.transpose(1, 0, 3, 2, 4).reshape(b, s, H_B, DV_B)
    o = rms_norm(o, norm_g).reshape(b, s, H_B * DV_B) * jax.nn.silu(g_in.astype(jnp.float32))
    return o.astype(g_in.dtype)


def short_conv(b_gate, c_gate, x_in, conv_w):
    h = c_gate * x_in
    s = h.shape[1]
    hp = jnp.pad(h, ((0, 0), (CONV_WIDTH - 1, 0), (0, 0)))
    y = conv_w[0] * hp[:, 0:s]
    for j in range(1, CONV_WIDTH):
        y = y + conv_w[j] * hp[:, j:j + s]
    return b_gate * y


def hier_moe(h, wg, bg, we, be, w_gate, w_up, w_down):
    t, d = h.shape
    hf = h.astype(jnp.float32)
    g_logits = hf @ wg.astype(jnp.float32) + bg.astype(jnp.float32)
    p_group = jax.nn.softmax(g_logits, axis=-1)
    g_idx = jnp.argmax(g_logits, axis=-1)
    p_g = jnp.take_along_axis(p_group, g_idx[:, None], axis=-1)
    e_logits = (hf @ we.astype(jnp.float32) + be.astype(jnp.float32)).reshape(t, N_GROUPS, EXPERTS_PER_GROUP)
    e_in_group = jnp.take_along_axis(e_logits, g_idx[:, None, None], axis=1)[:, 0]
    top_val, top_idx = lax.top_k(e_in_group, TOP_K_INNER)
    gates = p_g * jax.nn.softmax(top_val, axis=-1)
    expert_id = (g_idx[:, None] * EXPERTS_PER_GROUP + top_idx).reshape(-1)
    token_id = jnp.repeat(jnp.arange(t), TOP_K_INNER)
    n_assign = t * TOP_K_INNER
    order = jnp.argsort(expert_id)
    sorted_e = expert_id[order]
    counts = jnp.bincount(expert_id, length=N_EXPERTS)
    padded = (counts + MOE_BLOCK - 1) // MOE_BLOCK * MOE_BLOCK
    pad_end = jnp.cumsum(padded)
    pad_start = pad_end - padded
    raw_start = jnp.cumsum(counts) - counts
    dest = pad_start[sorted_e] + jnp.arange(n_assign) - raw_start[sorted_e]
    cap = -(-n_assign // MOE_BLOCK) * MOE_BLOCK + N_EXPERTS * MOE_BLOCK
    n_blocks = cap // MOE_BLOCK
    buf = jnp.zeros((cap, d), h.dtype).at[dest].set(h[token_id[order]])
    blk_e = jnp.minimum(jnp.searchsorted(pad_end, jnp.arange(n_blocks) * MOE_BLOCK, side='right'), N_EXPERTS - 1)

    def expert_block(args):
        xb, e = args
        return (jax.nn.silu(xb @ w_gate[e]) * (xb @ w_up[e])) @ w_down[e]

    y_buf = lax.map(expert_block, (buf.reshape(n_blocks, MOE_BLOCK, d), blk_e)).reshape(cap, d)
    y_assign = jnp.zeros((n_assign, d), y_buf.dtype).at[order].set(y_buf[dest])
    return jnp.einsum('tk,tkd->td', gates.astype(y_assign.dtype), y_assign.reshape(t, TOP_K_INNER, d))


def setup_inputs(seed: int = 0) -> dict:
    key = jax.random.key(seed)
    ks = jax.random.split(key, 24)
    f32 = jnp.float32

    def nrm(k, shape, scale):
        return jax.random.normal(k, shape, f32) * scale

    def gain(k, shape):
        return 1.0 + 0.02 * jax.random.normal(k, shape, f32)

    x = jax.random.normal(ks[0], (BATCH, SEQ, D_MODEL), f32)
    offsets = jax.random.randint(ks[1], (BATCH, 1), 0, 64, dtype=jnp.int32) * CHUNK
    positions = (offsets + jnp.arange(SEQ, dtype=jnp.int32)[None, :]).astype(jnp.int32)
    return {
        "x": x,
        "positions": positions,
        "norm_mix_g": gain(ks[2], (DEPTH, D_MODEL)),
        "w_in": nrm(ks[3], (DEPTH, D_MODEL, D_IN), D_MODEL ** -0.5),
        "attn_q_norm_g": gain(ks[4], (DEPTH, DK_A)),
        "attn_k_norm_g": gain(ks[5], (DEPTH, DK_A)),
        "lambda_q1": nrm(ks[6], (DEPTH, DK_A), 0.1),
        "lambda_k1": nrm(ks[7], (DEPTH, DK_A), 0.1),
        "lambda_q2": nrm(ks[8], (DEPTH, DK_A), 0.1),
        "lambda_k2": nrm(ks[9], (DEPTH, DK_A), 0.1),
        "attn_subln_g": gain(ks[10], (DEPTH, DV_A)),
        "hgrn_lower_bounds": nrm(ks[11], (DEPTH, H_B * DK_B), 0.5),
        "hgrn_norm_g": gain(ks[12], (DEPTH, DV_B)),
        "conv_w": nrm(ks[13], (DEPTH, CONV_WIDTH, C_WIDTH), CONV_WIDTH ** -0.5),
        "w_out": nrm(ks[14], (DEPTH, D_MIX, D_MODEL), D_MIX ** -0.5),
        "norm_ffn_g": gain(ks[15], (DEPTH, D_MODEL)),
        "router_group_w": nrm(ks[16], (DEPTH, D_MODEL, N_GROUPS), D_MODEL ** -0.5),
        "router_group_b": nrm(ks[17], (DEPTH, N_GROUPS), 0.01),
        "router_expert_w": nrm(ks[18], (DEPTH, D_MODEL, N_EXPERTS), D_MODEL ** -0.5),
        "router_expert_b": nrm(ks[19], (DEPTH, N_EXPERTS), 0.01),
        "expert_w_gate": nrm(ks[20], (DEPTH, N_EXPERTS, D_MODEL, D_EXPERT), D_MODEL ** -0.5),
        "expert_w_up": nrm(ks[21], (DEPTH, N_EXPERTS, D_MODEL, D_EXPERT), D_MODEL ** -0.5),
        "expert_w_down": nrm(ks[22], (DEPTH, N_EXPERTS, D_EXPERT, D_MODEL), D_EXPERT ** -0.5),
    }


def reference(x, positions, norm_mix_g, w_in, attn_q_norm_g, attn_k_norm_g, lambda_q1, lambda_k1,
              lambda_q2, lambda_k2, attn_subln_g, hgrn_lower_bounds, hgrn_norm_g, conv_w, w_out,
              norm_ffn_g, router_group_w, router_group_b, router_expert_w, router_expert_b,
              expert_w_gate, expert_w_up, expert_w_down):
    b, s, d = x.shape
    lb_probs = jax.nn.softmax(hgrn_lower_bounds.astype(jnp.float32), axis=0)
    lower_bounds = jnp.cumsum(lb_probs, axis=0) - lb_probs[0:1]
    split_points = [int(v) for v in np.cumsum(SPLIT_SIZES)[:-1]]
    for l in range(DEPTH):
        u = rms_norm(x, norm_mix_g[l]) @ w_in[l]
        aq, ak, av, bq, bf, bi, bg, cb, cc, cx = jnp.split(u, split_points, axis=-1)
        o_a = differential_attention(aq, ak, av, positions, attn_q_norm_g[l], attn_k_norm_g[l],
                                     lambda_q1[l], lambda_k1[l], lambda_q2[l], lambda_k2[l],
                                     attn_subln_g[l], l)
        o_b = hgrn2(bq, bf, bi, bg, lower_bounds[l], hgrn_norm_g[l])
        o_c = short_conv(cb, cc, cx, conv_w[l])
        mix = jnp.concatenate([o_a.astype(x.dtype), o_b.astype(x.dtype), o_c.astype(x.dtype)], axis=-1)
        x = x + mix @ w_out[l]
        h = rms_norm(x, norm_ffn_g[l]).reshape(b * s, d)
        y = hier_moe(h, router_group_w[l], router_group_b[l], router_expert_w[l], router_expert_b[l],
                     expert_w_gate[l], expert_w_up[l], expert_w_down[l])
        x = x + y.reshape(b, s, d).astype(x.dtype)
    return x
```

```cpp
#include <hip/hip_runtime.h>
#include <hip/hip_bf16.h>
#include <cstdio>
#include <cstdint>

#define LAS __attribute__((address_space(3)))
#define GAS __attribute__((address_space(1)))

#ifndef MK_N_LAUNCHES
#define MK_N_LAUNCHES 0
#endif

constexpr int D = 1024, BATCH = 32, SEQ = 2048, M = BATCH * SEQ, DEPTH = 2;
constexpr int DIN = 3328, NEXP = 32, DEXP = 512;
constexpr int CAP = 2 * M + NEXP * 256;
constexpr int AQ = 0, AK = 512, AV = 1024, BQ = 1536, BF = 1792, BI = 2048, BG = 2304, CB = 2560, CC = 2816, CX = 3072;
constexpr float EPS = 1e-6f;
constexpr float QSCALE = 0.125f * 1.4426950408889634f;

namespace pg8 {
typedef unsigned short bf16_t;
typedef short bf16x8 __attribute__((ext_vector_type(8)));
typedef float f32x4 __attribute__((ext_vector_type(4)));
typedef unsigned u32x4 __attribute__((ext_vector_type(4)));
constexpr int BM = 256, BK = 64, HALF = 128, HTB = HALF * BK * 2, STAGE_BYTES = 8 * HTB, NXCD = 8, WGM = 8;

__host__ __device__ __forceinline__ int lds_byte(int r, int c) { const int st = (r >> 4) * 2 + (c >> 5), rr = r & 15, cc = c & 31, ob = rr * 64 + cc * 2; return st * 1024 + (ob ^ (((ob >> 9) & 1) << 5)); }
__host__ __device__ __forceinline__ void stage_rc(int b, int& R, int& C) { const int st = b / 1024, sb = b % 1024, swz = sb ^ (((sb >> 9) & 1) << 5); R = (st >> 1) * 16 + swz / 64; C = (st & 1) * 32 + (swz % 64) / 2; }
__host__ __device__ __forceinline__ int perm32(int rho) { const int n = rho >> 4, i = rho & 15; return 8 * (i >> 2) + 4 * n + (i & 3); }

struct Unit { const char* A; const char* B; int row0; int col0; };

struct DenseOrder {
    const char* A; const char* Bt; int K; int nM, nN, nwg, G, c;
    __device__ void init(const void* A_, const void* Bt_, int M_, int N_, int K_, int G_, int c_) { A = (const char*)A_; Bt = (const char*)Bt_; K = K_; nM = M_ / BM; nN = N_ / BM; nwg = nM * nN; G = G_; c = c_; }
    __device__ bool next(int i, Unit& u) const {
        const long L = (long)i * G + c; if (L >= nwg) return false;
        int wgid = (int)L; { const int q = nwg / NXCD, r = nwg % NXCD, xcd = wgid % NXCD, off = wgid / NXCD; wgid = (xcd < r ? xcd * (q + 1) : r * (q + 1) + (xcd - r) * q) + off; }
        const int nig = WGM * nN, gid = wgid / nig, fm = gid * WGM, gsz = (nM - fm) < WGM ? (nM - fm) : WGM;
        const int pm = fm + ((wgid % nig) % gsz), pn = (wgid % nig) / gsz;
        u.A = A + (size_t)pm * BM * K * 2; u.B = Bt + (size_t)pn * BM * K * 2; u.row0 = pm * BM; u.col0 = pn * BM; return true;
    }
};
__device__ __forceinline__ int lds_ld_asm(unsigned addr) { int v; asm volatile("ds_read_b32 %0, %1\n\ts_waitcnt lgkmcnt(0)" : "=&v"(v) : "v"(addr) : "memory"); return v; }
struct MoeOrder {
    const char* A; const char* W; int K; size_t wstride; unsigned tab; int colw;
    __device__ bool next(int i, Unit& u) const {
        if (i >= 16) return false;
        const int p = __builtin_amdgcn_readfirstlane(lds_ld_asm(tab + 4u * (unsigned)i));
        if (p < 0) return false;
        const int e = p >> 24, L = p & 0xffffff, rt = L >> 2, pn = L & 3;
        u.A = A + (size_t)rt * BM * K * 2; u.B = W + (size_t)e * wstride + (size_t)pn * BM * K * 2; u.row0 = rt * BM; u.col0 = pn * colw; return true;
    }
};

__device__ __forceinline__ unsigned cvt_pk_bf16(float lo, float hi) { unsigned r; asm volatile("v_cvt_pk_bf16_f32 %0, %1, %2" : "=v"(r) : "v"(lo), "v"(hi)); return r; }

struct EpiStoreBf16 {
    static constexpr bool PERM = true;
    bf16_t* O; int ldc;
    __device__ __forceinline__ void operator()(const f32x4 (&acc)[2][2][4][2], const Unit& u, int wr, int wc, int fr, int fq) const {
        const int row0 = u.row0 + wr * 64 + fr, col0 = u.col0 + wc * 32 + 8 * fq;
#pragma unroll
        for (int ai = 0; ai < 2; ++ai)
#pragma unroll
            for (int m = 0; m < 4; ++m) { bf16_t* rowp = O + (size_t)(row0 + ai * HALF + m * 16) * ldc + col0;
#pragma unroll
                for (int bj = 0; bj < 2; ++bj) { const f32x4 v0 = acc[ai][bj][m][0], v1 = acc[ai][bj][m][1];
                    u32x4 w; w.x = cvt_pk_bf16(v0[0], v0[1]); w.y = cvt_pk_bf16(v0[2], v0[3]); w.z = cvt_pk_bf16(v1[0], v1[1]); w.w = cvt_pk_bf16(v1[2], v1[3]);
                    *(u32x4*)(rowp + bj * HALF) = w; } }
    }
};
struct EpiSwiGLU {
    static constexpr bool PERM = true;
    bf16_t* O;
    __device__ __forceinline__ void operator()(const f32x4 (&acc)[2][2][4][2], const Unit& u, int wr, int wc, int fr, int fq) const {
        const int row0 = u.row0 + wr * 64 + fr, col0 = u.col0 + wc * 32 + 8 * fq;
#pragma unroll
        for (int ai = 0; ai < 2; ++ai)
#pragma unroll
            for (int m = 0; m < 4; ++m) { bf16_t* rowp = O + (size_t)(row0 + ai * HALF + m * 16) * DEXP + col0;
                float a[8];
#pragma unroll
                for (int n = 0; n < 2; ++n)
#pragma unroll
                    for (int j = 0; j < 4; ++j) { const float g = acc[ai][0][m][n][j], up = acc[ai][1][m][n][j];
                        a[n * 4 + j] = g * __builtin_amdgcn_rcpf(1.0f + __builtin_amdgcn_exp2f(-1.4426950408889634f * g)) * up; }
                u32x4 w; w.x = cvt_pk_bf16(a[0], a[1]); w.y = cvt_pk_bf16(a[2], a[3]); w.z = cvt_pk_bf16(a[4], a[5]); w.w = cvt_pk_bf16(a[6], a[7]);
                *(u32x4*)rowp = w; }
    }
};
struct EpiResF32 {
    static constexpr bool PERM = false;
    const float* base; float* out;
    __device__ __forceinline__ void operator()(const f32x4 (&acc)[2][2][4][2], const Unit& u, int wr, int wc, int fr, int fq) const {
        const int row0 = u.row0 + wr * 64 + fr, col0 = u.col0 + wc * 32 + 4 * fq;
#pragma unroll
        for (int ai = 0; ai < 2; ++ai)
#pragma unroll
            for (int m = 0; m < 4; ++m) { const size_t off = (size_t)(row0 + ai * HALF + m * 16) * D + col0;
#pragma unroll
                for (int bj = 0; bj < 2; ++bj)
#pragma unroll
                    for (int n = 0; n < 2; ++n) { const f32x4 bs = *(const f32x4*)(base + off + bj * HALF + n * 16); *(f32x4*)(out + off + bj * HALF + n * 16) = bs + acc[ai][bj][m][n]; } }
    }
};

template <class Epi, class Sched, bool ALIGN_EPI = true>
__device__ __forceinline__ void gemm_phase(LAS unsigned char* lds, const int K, const Sched& S, const Epi& E, const int tid) {
    const int wid = __builtin_amdgcn_readfirstlane(tid >> 6), lane = tid & 63, wr = wid >> 2, wc = wid & 3, fr = lane & 15, fq = lane >> 4;
    const int nt = K / BK;
    unsigned voffA[2], voffB[2];
#pragma unroll
    for (int i = 0; i < 2; ++i) { int R, C; stage_rc(tid * 16 + i * 8192, R, C); const int Rb = Epi::PERM ? ((R & ~31) + perm32(R & 31)) : R;
        voffA[i] = (unsigned)(R * K + C) * 2u; voffB[i] = (unsigned)(Rb * K + C) * 2u; }
    const size_t kstep = (size_t)(BK * 2);
    const size_t hstep = (size_t)HALF * K * 2;
    const unsigned ldsw = (unsigned)wid * 1024u;
    const int aoff = lds_byte(wr * 64 + fr, fq * 8), boff = lds_byte(wc * 32 + fr, fq * 8);
#define PG8_SA(b, h) (((b) * 2 + (h)) * HTB)
#define PG8_SB(b, h) ((4 + (b) * 2 + (h)) * HTB)
#define PG8_STAGE(bufoff, gbase, voff) do { _Pragma("unroll") for (int _i = 0; _i < 2; ++_i) \
        __builtin_amdgcn_global_load_lds((const unsigned*)((const char*)(gbase) + (voff)[_i]), (LAS unsigned*)(lds + (bufoff) + ldsw + _i * 8192), 16, 0, 0); } while (0)
#define PG8_LDA(dst, b, h) do { _Pragma("unroll") for (int m = 0; m < 4; ++m) _Pragma("unroll") for (int k = 0; k < 2; ++k) dst[m][k] = *(const LAS bf16x8*)(lds + PG8_SA(b, h) + aoff + m * 2048 + k * 1024); } while (0)
#define PG8_LDB(dst, b, h) do { _Pragma("unroll") for (int n = 0; n < 2; ++n) _Pragma("unroll") for (int k = 0; k < 2; ++k) dst[n][k] = *(const LAS bf16x8*)(lds + PG8_SB(b, h) + boff + n * 2048 + k * 1024); } while (0)
#define PG8_MMA(ai, bj, At, Bt) do { __builtin_amdgcn_s_setprio(1); _Pragma("unroll") for (int m = 0; m < 4; ++m) _Pragma("unroll") for (int n = 0; n < 2; ++n) _Pragma("unroll") for (int k = 0; k < 2; ++k) \
        acc[ai][bj][m][n] = __builtin_amdgcn_mfma_f32_16x16x32_bf16(Bt[n][k], At[m][k], acc[ai][bj][m][n], 0, 0, 0); __builtin_amdgcn_s_setprio(0); } while (0)
#define PG8_WAIT_V(n) asm volatile("s_waitcnt vmcnt(" #n ")" ::: "memory")
#define PG8_WAIT_L(n) asm volatile("s_waitcnt lgkmcnt(" #n ")" ::: "memory")
#define PG8_BAR __builtin_amdgcn_s_barrier()
#define PG8_SCHED __builtin_amdgcn_sched_barrier(0)
    Unit cur, nxt; int ui = 0;
    if (!S.next(0, cur)) return;
    f32x4 acc[2][2][4][2];
#pragma unroll
    for (int a = 0; a < 2; ++a)
#pragma unroll
        for (int b = 0; b < 2; ++b)
#pragma unroll
            for (int m = 0; m < 4; ++m)
#pragma unroll
                for (int n = 0; n < 2; ++n) acc[a][b][m][n] = (f32x4){0.f, 0.f, 0.f, 0.f};
    bf16x8 At[4][2], B0[2][2], B1[2][2];
    const char* cA = cur.A; const char* cB = cur.B;
    PG8_STAGE(PG8_SB(0, 0), cB, voffB); PG8_STAGE(PG8_SB(0, 1), cB + hstep, voffB); PG8_STAGE(PG8_SA(0, 0), cA, voffA); PG8_STAGE(PG8_SA(0, 1), cA + hstep, voffA);
    if (wr == 1) PG8_BAR;
    PG8_WAIT_V(2); PG8_BAR;
    PG8_STAGE(PG8_SB(1, 0), cB + kstep, voffB); PG8_STAGE(PG8_SA(1, 0), cA + kstep, voffA); PG8_STAGE(PG8_SB(1, 1), cB + hstep + kstep, voffB);
    PG8_WAIT_V(6); PG8_BAR;
    for (;;) {
        const bool has_next = S.next(ui + 1, nxt);
        const char* nA = has_next ? nxt.A : cA; const char* nB = has_next ? nxt.B : cB;
        for (int t = 0; t < nt; t += 2) {
            const bool last = (t == nt - 2);
            const char* a1 = cA + (size_t)(t + 1) * kstep;
            const char* a2 = last ? nA : cA + (size_t)(t + 2) * kstep; const char* b2 = last ? nB : cB + (size_t)(t + 2) * kstep;
            const char* a3 = a2 + kstep; const char* b3 = b2 + kstep;
            PG8_LDB(B0, 0, 0); PG8_LDB(B1, 0, 1); PG8_SCHED; PG8_LDA(At, 0, 0); PG8_STAGE(PG8_SA(1, 1), a1 + hstep, voffA);
            PG8_WAIT_V(8); PG8_WAIT_L(0); PG8_BAR; PG8_MMA(0, 0, At, B0); PG8_MMA(0, 1, At, B1); PG8_BAR; PG8_SCHED;
            PG8_LDA(At, 0, 1); PG8_STAGE(PG8_SB(0, 0), b2, voffB); PG8_STAGE(PG8_SB(0, 1), b2 + hstep, voffB); PG8_STAGE(PG8_SA(0, 0), a2, voffA);
            PG8_WAIT_V(8); PG8_WAIT_L(0); PG8_BAR; PG8_MMA(1, 0, At, B0); PG8_MMA(1, 1, At, B1); PG8_BAR; PG8_SCHED;
            PG8_LDB(B0, 1, 0); PG8_LDB(B1, 1, 1); PG8_SCHED; PG8_LDA(At, 1, 0); PG8_STAGE(PG8_SA(0, 1), a2 + hstep, voffA);
            PG8_WAIT_V(8); PG8_WAIT_L(0); PG8_BAR; PG8_MMA(0, 0, At, B0); PG8_MMA(0, 1, At, B1); PG8_BAR; PG8_SCHED;
            PG8_LDA(At, 1, 1); PG8_STAGE(PG8_SB(1, 0), b3, voffB); PG8_STAGE(PG8_SB(1, 1), b3 + hstep, voffB); PG8_STAGE(PG8_SA(1, 0), a3, voffA);
            PG8_WAIT_V(8); PG8_WAIT_L(0); PG8_BAR; PG8_MMA(1, 0, At, B0); PG8_MMA(1, 1, At, B1); PG8_BAR; PG8_SCHED;
        }
        if constexpr (ALIGN_EPI) { if (wr == 0) PG8_BAR; }
        E(acc, cur, wr, wc, fr, fq);
        if (!has_next) break;
#pragma unroll
        for (int a = 0; a < 2; ++a)
#pragma unroll
            for (int b = 0; b < 2; ++b)
#pragma unroll
                for (int m = 0; m < 4; ++m)
#pragma unroll
                    for (int n = 0; n < 2; ++n) acc[a][b][m][n] = (f32x4){0.f, 0.f, 0.f, 0.f};
        cur = nxt; cA = nA; cB = nB; ++ui;
        if constexpr (ALIGN_EPI) { if (wr == 1) PG8_BAR; }
    }
    PG8_WAIT_V(0);
    if constexpr (!ALIGN_EPI) { if (wr == 0) PG8_BAR; }
    PG8_BAR;
#undef PG8_SA
#undef PG8_SB
#undef PG8_STAGE
#undef PG8_LDA
#undef PG8_LDB
#undef PG8_MMA
#undef PG8_WAIT_V
#undef PG8_WAIT_L
#undef PG8_BAR
#undef PG8_SCHED
}
}

constexpr size_t MiB = 1u << 20;
constexpr size_t WS_CTL = 0, CTL_ZERO_BYTES = 1 * MiB;
constexpr size_t WS_MISC = 1 * MiB;
constexpr size_t MISC_LAM = 0;
constexpr size_t MISC_LB = 1024;
constexpr size_t MISC_WRT = 64 * 1024;
constexpr size_t MISC_ROPE = 1 * MiB;
constexpr size_t MISC_TOKPOS = 6 * MiB;
constexpr size_t MISC_TOKGATE = 7 * MiB;
constexpr size_t MISC_TOKSLOT = 8 * MiB;
constexpr size_t WS_WIN = 17 * MiB;
constexpr size_t WS_WOUT = 30 * MiB;
constexpr size_t WS_WGU = 34 * MiB;
constexpr size_t WS_WD = 162 * MiB;
constexpr size_t WS_U = 226 * MiB;
constexpr size_t WS_XG = WS_U, WS_ACT = WS_U + 272 * MiB;
constexpr size_t WS_MIX = 642 * MiB;
constexpr size_t WS_XN = 770 * MiB;
constexpr size_t WS_RAWO = 898 * MiB;
constexpr size_t WS_END = 962 * MiB;
static_assert((size_t)CAP * 1024 * 2 <= 272 * MiB && (size_t)CAP * 512 * 2 <= 136 * MiB && (size_t)M * DIN * 2 <= 416 * MiB, "ws map");
constexpr int CW_BAR = 4096;
constexpr int CW_CNT = 16384;

constexpr int RING_OFF = 0, RING_BYTES = 131072;
constexpr int LDSCTL_OFF = RING_BYTES, MISC_OFF = LDSCTL_OFF + 320;
constexpr int TAB_OFF = LDSCTL_OFF + 1024;
constexpr int LDS_BYTES = 147456;

typedef unsigned short bf16;
typedef unsigned v4u __attribute__((ext_vector_type(4)));
typedef unsigned v2u __attribute__((ext_vector_type(2)));
typedef float f32x4 __attribute__((ext_vector_type(4)));
typedef float f32x16 __attribute__((ext_vector_type(16)));
typedef short bf16x8 __attribute__((ext_vector_type(8)));
typedef short s16x4 __attribute__((ext_vector_type(4)));
typedef GAS unsigned gu32;
#define RLX_AGENT __ATOMIC_RELAXED, __HIP_MEMORY_SCOPE_AGENT
#define LDS_WAIT() asm volatile("s_waitcnt lgkmcnt(0)" ::: "memory")
#define VM_WAIT() asm volatile("s_waitcnt vmcnt(0)" ::: "memory")
typedef float f32x2_t __attribute__((ext_vector_type(2))); typedef __bf16 bf16x2_t __attribute__((ext_vector_type(2)));
__device__ __forceinline__ unsigned pk2(float lo, float hi) { f32x2_t v = {lo, hi}; bf16x2_t b = __builtin_convertvector(v, bf16x2_t); return __builtin_bit_cast(unsigned, b); }
__device__ __forceinline__ float bflo(unsigned w) { return __uint_as_float(w << 16); }
__device__ __forceinline__ float bfhi(unsigned w) { return __uint_as_float(w & 0xffff0000u); }
__device__ __forceinline__ float fsigmoid(float z) { return __builtin_amdgcn_rcpf(1.0f + __builtin_amdgcn_exp2f(-1.4426950408889634f * z)); }

#define XB_TMO      128
#define XB_XCNT(j)  (256  + 64 * (j))
#define XB_XSUB(j)  (1280 + 64 * (j))
#define XB_XGEN(j)  (2304 + 64 * (j))
#define XB_TOP      3328
#define XB_TOPGEN   3392
#define XCD_BAR_WORDS 3456
#define XB_SPIN_CAP (1u << 18)
__device__ __forceinline__ unsigned xb_ld(unsigned* p)              { return __hip_atomic_load(p, __ATOMIC_RELAXED, __HIP_MEMORY_SCOPE_AGENT); }
__device__ __forceinline__ unsigned xb_add(unsigned* p, unsigned v) { return __hip_atomic_fetch_add(p, v, __ATOMIC_RELAXED, __HIP_MEMORY_SCOPE_AGENT); }
__device__ __forceinline__ unsigned xb_xcc_id() { return (unsigned)__builtin_amdgcn_s_getreg((3 << 11) | 20) & 0xFu; }
#define XB_SPIN(cond, bar) do { unsigned _sp = 0; while (cond) { __builtin_amdgcn_s_sleep(1); \
    if ((++_sp & 255u) == 0u) { if (xb_ld(&(bar)[XB_TMO])) break; if (_sp > XB_SPIN_CAP) { atomicAdd(&(bar)[XB_TMO], 1u); break; } } } } while (0)
struct XcdBarrier { unsigned* bar; unsigned x; volatile LAS unsigned* st; };
__device__ __forceinline__ XcdBarrier xcd_barrier_post(unsigned* bar, volatile LAS unsigned* st) {
    XcdBarrier b; b.bar = bar; b.x = xb_xcc_id(); b.st = st;
    if (threadIdx.x == 0) (void)xb_add(&bar[XB_XCNT(b.x)], 1u);
    return b;
}
__device__ __forceinline__ void xcd_barrier_complete(unsigned* bar, unsigned x, unsigned& nloc, unsigned& nx) {
    const unsigned G = gridDim.x * gridDim.y * gridDim.z;
    unsigned sum, cnt, mine, sp = 0u;
    for (;;) {
        sum = 0u; cnt = 0u; mine = 0u;
#pragma unroll
        for (unsigned j = 0; j < 16; ++j) { const unsigned c = xb_ld(&bar[XB_XCNT(j)]); sum += c; cnt += (c > 0u) ? 1u : 0u; mine = (j == x) ? c : mine; }
        if (sum == G) break;
        __builtin_amdgcn_s_sleep(1);
        if ((++sp & 255u) == 0u) { if (xb_ld(&bar[XB_TMO])) break; if (sp > XB_SPIN_CAP) { atomicAdd(&bar[XB_TMO], 1u); break; } }
    }
    nloc = mine > 0u ? mine : 1u; nx = cnt > 0u ? cnt : 1u;
}
__device__ __forceinline__ void xcd_barrier(const XcdBarrier& b) {
    asm volatile("s_waitcnt vmcnt(0)" ::: "memory");
    __syncthreads();
    if (threadIdx.x == 0) {
        unsigned* bar = b.bar;
        __builtin_amdgcn_s_waitcnt(0);
        unsigned nloc = b.st[0], nx = b.st[1];
        if (nloc == 0u) { xcd_barrier_complete(bar, b.x, nloc, nx); b.st[0] = nloc; b.st[1] = nx; }
        const unsigned old = xb_add(&bar[XB_XSUB(b.x)], 1u);
        const unsigned gen = old / nloc;
        if (old + 1u == (gen + 1u) * nloc) {
            __builtin_amdgcn_fence(__ATOMIC_RELEASE, "agent");
            asm volatile("s_waitcnt vmcnt(0)" ::: "memory");
            const unsigned og = xb_add(&bar[XB_TOP], 1u);
            const unsigned tg = og / nx;
            if (og + 1u == (tg + 1u) * nx) xb_add(&bar[XB_TOPGEN], 1u);
            else XB_SPIN(xb_ld(&bar[XB_TOPGEN]) == tg, bar);
            __builtin_amdgcn_fence(__ATOMIC_ACQUIRE, "agent");
            xb_add(&bar[XB_XGEN(b.x)], 1u);
            asm volatile("s_waitcnt vmcnt(0)" ::: "memory");
        } else {
            XB_SPIN(xb_ld(&bar[XB_XGEN(b.x)]) == gen, bar);
            __builtin_amdgcn_fence(__ATOMIC_ACQUIRE, "agent");
            asm volatile("s_waitcnt vmcnt(0)" ::: "memory");
        }
    }
    __syncthreads();
}

struct Args { const float* in[23]; float* out; unsigned char* ws; int ph_lo, ph_hi; };
struct Frame {
    LAS unsigned char* lds;
    volatile LAS unsigned* MISC;
    gu32* ctl;
    int tid, lane, wave;
    int vcu, G;
    float* out; unsigned char* ws;
};
__device__ __forceinline__ float wave_sum(float v) {
#pragma unroll
    for (int o = 1; o < 64; o <<= 1) v += __shfl_xor(v, o);
    return v;
}

__device__ __forceinline__ void p0_transpose_item(const float* W, int K, int N, bf16* WT, int dst_row0, int k0, int n0, LAS float* scr, int lane) {
#pragma unroll 8
    for (int i = 0; i < 32; ++i) { const int kk = 2 * i + (lane >> 5); scr[kk * 33 + (lane & 31)] = W[(size_t)(k0 + kk) * N + n0 + (lane & 31)]; }
    LDS_WAIT(); asm volatile("" ::: "memory");
    const int c = lane & 7;
#pragma unroll
    for (int j = 0; j < 4; ++j) { const int n = (lane >> 3) + 8 * j; const LAS float* s = scr + (8 * c) * 33 + n;
        v4u o; o.x = pk2(s[0 * 33], s[1 * 33]); o.y = pk2(s[2 * 33], s[3 * 33]); o.z = pk2(s[4 * 33], s[5 * 33]); o.w = pk2(s[6 * 33], s[7 * 33]);
        *(GAS v4u*)(WT + (size_t)(dst_row0 + n) * K + k0 + 8 * c) = o; }
    LDS_WAIT(); asm volatile("" ::: "memory");
}
__device__ __forceinline__ void rms_row_to_bf16(const float* xrow, const float* g, bf16* orow, int lane) {
    const GAS f32x4* xr = (const GAS f32x4*)xrow + lane; const GAS f32x4* gr = (const GAS f32x4*)g + lane;
    f32x4 v[4]; float s = 0.f;
#pragma unroll
    for (int j = 0; j < 4; ++j) { v[j] = xr[64 * j]; s += (v[j].x * v[j].x + v[j].y * v[j].y) + (v[j].z * v[j].z + v[j].w * v[j].w); }
    const float rstd = 1.0f / sqrtf(wave_sum(s) * (1.f / D) + EPS);
    GAS unsigned long long* o8 = (GAS unsigned long long*)orow + lane;
#pragma unroll
    for (int j = 0; j < 4; ++j) { const f32x4 gg = gr[64 * j]; o8[64 * j] = (unsigned long long)pk2(v[j].x * rstd * gg.x, v[j].y * rstd * gg.y) | ((unsigned long long)pk2(v[j].z * rstd * gg.z, v[j].w * rstd * gg.w) << 32); }
}
__device__ __forceinline__ void p0_prologue(const Args& A, Frame& F) {
    LAS float* scr = (LAS float*)(F.lds + RING_OFF + F.wave * 16384);
    const int gw = F.vcu * 8 + F.wave, NGW = F.G * 8;
    unsigned char* ws = F.ws;
    constexpr int I_WIN = 16 * 104, I_WOUT = 16 * 32, I_G = 16 * 16, I_D = 8 * 32;
    constexpr int N_WIN = 2 * I_WIN, N_WOUT = 2 * I_WOUT, N_G = 64 * I_G, N_D = 64 * I_D;
    constexpr int NITEMS = N_WIN + N_WOUT + 2 * N_G + N_D;
    for (int it = gw; it < NITEMS; it += NGW) {
        int r = it;
        if (r < N_WIN) { const int l = r / I_WIN, q = r % I_WIN, kb = q / 104, nb = q % 104;
            p0_transpose_item(A.in[3] + (size_t)l * D * DIN, D, DIN, (bf16*)(ws + WS_WIN) + (size_t)l * DIN * D, 32 * nb, 64 * kb, 32 * nb, scr, F.lane); continue; } r -= N_WIN;
        if (r < N_WOUT) { const int l = r / I_WOUT, q = r % I_WOUT, kb = q / 32, nb = q % 32;
            p0_transpose_item(A.in[14] + (size_t)l * D * D, D, D, (bf16*)(ws + WS_WOUT) + (size_t)l * D * D, 32 * nb, 64 * kb, 32 * nb, scr, F.lane); continue; } r -= N_WOUT;
        if (r < N_G) { const int le = r / I_G, q = r % I_G, kb = q / 16, nb = q % 16, n0 = 32 * nb;
            p0_transpose_item(A.in[20] + (size_t)le * D * DEXP, D, DEXP, (bf16*)(ws + WS_WGU) + (size_t)le * D * D, (n0 >> 7) * 256 + (n0 & 127), 64 * kb, n0, scr, F.lane); continue; } r -= N_G;
        if (r < N_G) { const int le = r / I_G, q = r % I_G, kb = q / 16, nb = q % 16, n0 = 32 * nb;
            p0_transpose_item(A.in[21] + (size_t)le * D * DEXP, D, DEXP, (bf16*)(ws + WS_WGU) + (size_t)le * D * D, (n0 >> 7) * 256 + 128 + (n0 & 127), 64 * kb, n0, scr, F.lane); continue; } r -= N_G;
        { const int le = r / I_D, q = r % I_D, kb = q / 32, nb = q % 32;
            p0_transpose_item(A.in[22] + (size_t)le * DEXP * D, DEXP, D, (bf16*)(ws + WS_WD) + (size_t)le * D * DEXP, 32 * nb, 64 * kb, 32 * nb, scr, F.lane); }
    }
    const int gt = F.vcu * 512 + F.tid, NGT = F.G * 512;
    { float* WrT = (float*)(ws + WS_MISC + MISC_WRT);
      for (int i = gt; i < 2 * 36 * 1024; i += NGT) { const int l = i / (36 * 1024), o = (i / 1024) % 36, k = i % 1024;
          WrT[i] = (o < 32) ? A.in[18][((size_t)l * D + k) * 32 + o] : A.in[16][((size_t)l * D + k) * 4 + (o - 32)]; } }
    { float* rope = (float*)(ws + WS_MISC + MISC_ROPE); const int* pos = (const int*)A.in[1];
      for (int i = gt; i < M * 8; i += NGT) { const int m = i >> 3, f = i & 7;
          const float invf = exp2f(-(float)f * (18.931568569324174f / 8.0f));
          const float ang = (float)pos[m] * invf; float sn, cs; sincosf(ang, &sn, &cs);
          rope[(size_t)m * 16 + f] = cs; rope[(size_t)m * 16 + 8 + f] = sn; } }
    if (gt < 2) { const int l = gt; float s1 = 0.f, s2 = 0.f;
        for (int i = 0; i < 64; ++i) { s1 += A.in[6][l * 64 + i] * A.in[7][l * 64 + i]; s2 += A.in[8][l * 64 + i] * A.in[9][l * 64 + i]; }
        const float lam_init = 0.8f - 0.6f * expf(-0.3f * (float)l);
        ((float*)(ws + WS_MISC + MISC_LAM))[l] = expf(s1) - expf(s2) + lam_init; }
    if (gt >= 512 && gt < 512 + 256) { const int j = gt - 512; const float h0 = A.in[11][j], h1 = A.in[11][256 + j];
        float* lb = (float*)(ws + WS_MISC + MISC_LB); lb[j] = 0.f; lb[256 + j] = 1.0f / (1.0f + expf(h0 - h1)); }
    for (int m = gw; m < M; m += NGW) rms_row_to_bf16(A.in[0] + (size_t)m * D, A.in[2], (bf16*)(ws + WS_XN) + (size_t)m * D, F.lane);
}

__device__ __forceinline__ void prep_phase(const Args& A, Frame& F, int l) {
    const int gw = F.vcu * 8 + F.wave, NGW = F.G * 8, lane = F.lane;
    bf16* u = (bf16*)(F.ws + WS_U); bf16* mix = (bf16*)(F.ws + WS_MIX);
    const float* rope = (const float*)(F.ws + WS_MISC + MISC_ROPE);
    const int grp = lane >> 2, sub = lane & 3;
    const float* gsrc = (grp < 8 ? A.in[4] : A.in[5]) + l * 64 + sub * 16;
    float gn[16];
#pragma unroll
    for (int j = 0; j < 16; ++j) gn[j] = gsrc[j] * (grp < 8 ? QSCALE : 1.0f);
    const float* cw = A.in[13] + (size_t)l * 3 * 256 + 4 * lane;
    const f32x4 w0 = *(const f32x4*)(cw), w1 = *(const f32x4*)(cw + 256), w2 = *(const f32x4*)(cw + 512);
    for (int m = gw; m < M; m += NGW) {
        bf16* row = u + (size_t)m * DIN;
        v4u a = *(GAS v4u*)(row + 16 * lane), b = *(GAS v4u*)(row + 16 * lane + 8);
        float v[16];
        v[0] = bflo(a.x); v[1] = bfhi(a.x); v[2] = bflo(a.y); v[3] = bfhi(a.y); v[4] = bflo(a.z); v[5] = bfhi(a.z); v[6] = bflo(a.w); v[7] = bfhi(a.w);
        v[8] = bflo(b.x); v[9] = bfhi(b.x); v[10] = bflo(b.y); v[11] = bfhi(b.y); v[12] = bflo(b.z); v[13] = bfhi(b.z); v[14] = bflo(b.w); v[15] = bfhi(b.w);
        float ss = 0.f;
#pragma unroll
        for (int j = 0; j < 16; ++j) ss += v[j] * v[j];
        ss += __shfl_xor(ss, 1); ss += __shfl_xor(ss, 2);
        const float rstd = 1.0f / sqrtf(ss * (1.f / 64.f) + EPS);
#pragma unroll
        for (int j = 0; j < 16; ++j) v[j] = v[j] * rstd * gn[j];
        if (sub == 0) {
            const f32x4 c0 = *(const f32x4*)(rope + (size_t)m * 16), c1 = *(const f32x4*)(rope + (size_t)m * 16 + 4), s0 = *(const f32x4*)(rope + (size_t)m * 16 + 8), s1 = *(const f32x4*)(rope + (size_t)m * 16 + 12);
            const float cs[8] = {c0.x, c0.y, c0.z, c0.w, c1.x, c1.y, c1.z, c1.w}, sn[8] = {s0.x, s0.y, s0.z, s0.w, s1.x, s1.y, s1.z, s1.w};
#pragma unroll
            for (int i = 0; i < 8; ++i) { const float t1 = v[i], t2 = v[8 + i]; v[i] = t1 * cs[i] - t2 * sn[i]; v[8 + i] = t1 * sn[i] + t2 * cs[i]; }
        }
        a.x = pk2(v[0], v[1]); a.y = pk2(v[2], v[3]); a.z = pk2(v[4], v[5]); a.w = pk2(v[6], v[7]);
        b.x = pk2(v[8], v[9]); b.y = pk2(v[10], v[11]); b.z = pk2(v[12], v[13]); b.w = pk2(v[14], v[15]);
        *(GAS v4u*)(row + 16 * lane) = a; *(GAS v4u*)(row + 16 * lane + 8) = b;
        const int s = m & (SEQ - 1);
        const v2u cbv = *(GAS v2u*)(row + CB + 4 * lane);
        f32x4 h0 = {0.f, 0.f, 0.f, 0.f}, h1 = h0, h2;
        { const v2u c = *(GAS v2u*)(row + CC + 4 * lane), x = *(GAS v2u*)(row + CX + 4 * lane);
          h2 = (f32x4){bflo(c.x) * bflo(x.x), bfhi(c.x) * bfhi(x.x), bflo(c.y) * bflo(x.y), bfhi(c.y) * bfhi(x.y)}; }
        if (s >= 1) { const bf16* r1 = row - DIN; const v2u c = *(GAS v2u*)(r1 + CC + 4 * lane), x = *(GAS v2u*)(r1 + CX + 4 * lane);
          h1 = (f32x4){bflo(c.x) * bflo(x.x), bfhi(c.x) * bfhi(x.x), bflo(c.y) * bflo(x.y), bfhi(c.y) * bfhi(x.y)}; }
        if (s >= 2) { const bf16* r2 = row - 2 * DIN; const v2u c = *(GAS v2u*)(r2 + CC + 4 * lane), x = *(GAS v2u*)(r2 + CX + 4 * lane);
          h0 = (f32x4){bflo(c.x) * bflo(x.x), bfhi(c.x) * bfhi(x.x), bflo(c.y) * bflo(x.y), bfhi(c.y) * bfhi(x.y)}; }
        const f32x4 cbf = {bflo(cbv.x), bfhi(cbv.x), bflo(cbv.y), bfhi(cbv.y)};
        const f32x4 y = cbf * (w0 * h0 + w1 * h1 + w2 * h2);
        v2u o; o.x = pk2(y.x, y.y); o.y = pk2(y.z, y.w);
        *(GAS v2u*)(mix + (size_t)m * D + 768 + 4 * lane) = o;
    }
}

__device__ __forceinline__ int crow(int r, int hi) { return (r & 3) + 8 * (r >> 2) + 4 * hi; }
typedef short v4i16_t __attribute__((ext_vector_type(4)));
__device__ __forceinline__ s16x4 vtr(const LAS unsigned char* p) { return __builtin_bit_cast(s16x4, __builtin_amdgcn_ds_read_tr16_b64_v4i16((LAS v4i16_t*)p)); }
constexpr int XS = 132;
__device__ __forceinline__ void attn_unit(Frame& F, const bf16* u, bf16* mix, int b, int h, int rb, float lam, float oscale, const float* subg) {
    const int lane = F.lane, r32 = lane & 31, hi = lane >> 5, wid = F.wave, rg = wid & 3, comp = wid >> 2;
    const size_t rowb = (size_t)b * SEQ; const int t0 = rb * 128;
    const int NT = 2 * rb + 2, ntw = 2 * rb + (rg >> 1) + 1;
    LAS unsigned char* lds = F.lds;
    const bf16* ksrc0 = u + (rowb + lane) * DIN + AK + h * 128 + wid * 8;
    const bf16* ksrc1 = ksrc0 + 64;
    const bf16* vsrcA = u + (rowb + 32 * (wid & 1) + (lane >> 2)) * DIN + AV + h * 128 + (wid >> 1) * 32 + (lane & 3) * 8;
    const bf16* vsrcB = vsrcA + 16 * DIN;
#define ATT_DMA(j, s) do { const size_t go = (size_t)(j) * 64 * DIN; LAS unsigned char* sb = lds + (s) * 32768 + wid * 1024; \
        __builtin_amdgcn_global_load_lds((const unsigned*)(ksrc0 + go), (LAS unsigned*)(sb), 16, 0, 0); \
        __builtin_amdgcn_global_load_lds((const unsigned*)(ksrc1 + go), (LAS unsigned*)(sb + 8192), 16, 0, 0); \
        __builtin_amdgcn_global_load_lds((const unsigned*)(vsrcA + go), (LAS unsigned*)(sb + 16384 + wid * 1024), 16, 0, 0); \
        __builtin_amdgcn_global_load_lds((const unsigned*)(vsrcB + go), (LAS unsigned*)(sb + 16384 + wid * 1024 + 1024), 16, 0, 0); } while (0)
    ATT_DMA(0, 0);
    const bf16* qp = u + (rowb + t0 + 32 * rg + r32) * DIN + AQ + h * 128 + comp * 64 + hi * 8;
    bf16x8 qr[4];
#pragma unroll
    for (int d0 = 0; d0 < 4; ++d0) qr[d0] = *(const GAS bf16x8*)(qp + d0 * 16);
    f32x16 o[4];
#pragma unroll
    for (int c = 0; c < 4; ++c)
#pragma unroll
        for (int r = 0; r < 16; ++r) o[c][r] = 0.f;
    float lsum = 0.f;
    VM_WAIT(); __syncthreads();
    for (int j = 0; j < NT; ++j) {
        const int s = j & 1;
        if (j + 1 < NT) ATT_DMA(j + 1, s ^ 1);
        if (j < ntw) {
            const LAS unsigned char* Kb = lds + s * 32768 + comp * 8192 + hi * 1024 + r32 * 16;
            f32x16 p0, p1;
#pragma unroll
            for (int r = 0; r < 16; ++r) { p0[r] = 0.f; p1[r] = 0.f; }
#pragma unroll
            for (int d0 = 0; d0 < 4; ++d0) {
                const bf16x8 k0 = *(const LAS bf16x8*)(Kb + d0 * 2048), k1 = *(const LAS bf16x8*)(Kb + d0 * 2048 + 512);
                p0 = __builtin_amdgcn_mfma_f32_32x32x16_bf16(k0, qr[d0], p0, 0, 0, 0);
                p1 = __builtin_amdgcn_mfma_f32_32x32x16_bf16(k1, qr[d0], p1, 0, 0, 0);
            }
            float sacc = 0.f;
#pragma unroll
            for (int r = 0; r < 16; ++r) { p0[r] = __builtin_amdgcn_exp2f(p0[r]); p1[r] = __builtin_amdgcn_exp2f(p1[r]); sacc += p0[r] + p1[r]; }
            lsum += sacc;
            v4u pw[4];
            pw[0] = (v4u){pk2(p0[0], p0[1]), pk2(p0[2], p0[3]), pk2(p0[4], p0[5]), pk2(p0[6], p0[7])};
            pw[1] = (v4u){pk2(p0[8], p0[9]), pk2(p0[10], p0[11]), pk2(p0[12], p0[13]), pk2(p0[14], p0[15])};
            pw[2] = (v4u){pk2(p1[0], p1[1]), pk2(p1[2], p1[3]), pk2(p1[4], p1[5]), pk2(p1[6], p1[7])};
            pw[3] = (v4u){pk2(p1[8], p1[9]), pk2(p1[10], p1[11]), pk2(p1[12], p1[13]), pk2(p1[14], p1[15])};
            const LAS unsigned char* Vb = lds + s * 32768 + 16384 + ((lane >> 4) & 1) * 32 + (lane & 3) * 8 + (4 * hi + ((lane & 15) >> 2)) * 64;
#pragma unroll
            for (int cb = 0; cb < 4; ++cb)
#pragma unroll
                for (int ks = 0; ks < 4; ++ks) {
                    const s16x4 lo = vtr(Vb + cb * 4096 + ks * 1024), hh = vtr(Vb + cb * 4096 + ks * 1024 + 512);
                    const bf16x8 vf = {lo[0], lo[1], lo[2], lo[3], hh[0], hh[1], hh[2], hh[3]};
                    o[cb] = __builtin_amdgcn_mfma_f32_32x32x16_bf16(__builtin_bit_cast(bf16x8, pw[ks]), vf, o[cb], 0, 0, 0);
                }
        }
        VM_WAIT(); __syncthreads();
    }
#undef ATT_DMA
    lsum += __shfl_xor(lsum, 32);
    float inv[16];
#pragma unroll
    for (int r = 0; r < 16; ++r) inv[r] = 1.0f / __shfl(lsum, crow(r, hi));
    LAS float* X = (LAS float*)lds;
    if (comp == 1) {
#pragma unroll
        for (int cb = 0; cb < 4; ++cb)
#pragma unroll
            for (int r = 0; r < 16; ++r) X[(32 * rg + crow(r, hi)) * XS + cb * 32 + r32] = lam * o[cb][r] * inv[r];
    }
    __syncthreads();
    if (comp == 0) {
#pragma unroll
        for (int cb = 0; cb < 4; ++cb)
#pragma unroll
            for (int r = 0; r < 16; ++r) { const int idx = (32 * rg + crow(r, hi)) * XS + cb * 32 + r32; X[idx] = o[cb][r] * inv[r] - X[idx]; }
    }
    __syncthreads();
    {
        const int row = 16 * wid + (lane >> 2), c0 = (lane & 3) * 32;
        f32x4 dv[8]; float ss = 0.f;
#pragma unroll
        for (int i = 0; i < 8; ++i) { dv[i] = *(const LAS f32x4*)(X + row * XS + c0 + 4 * i); ss += (dv[i].x * dv[i].x + dv[i].y * dv[i].y) + (dv[i].z * dv[i].z + dv[i].w * dv[i].w); }
        ss += __shfl_xor(ss, 1); ss += __shfl_xor(ss, 2);
        const float rstd = oscale / sqrtf(ss * (1.f / 128.f) + EPS);
        bf16* op = mix + (rowb + t0 + row) * D + h * 128 + c0;
#pragma unroll
        for (int i = 0; i < 4; ++i) { const f32x4 g0 = *(const f32x4*)(subg + c0 + 8 * i), g1 = *(const f32x4*)(subg + c0 + 8 * i + 4); const f32x4 a = dv[2 * i] * g0 * rstd, c = dv[2 * i + 1] * g1 * rstd;
            v4u w; w.x = pk2(a.x, a.y); w.y = pk2(a.z, a.w); w.z = pk2(c.x, c.y); w.w = pk2(c.z, c.w); *(GAS v4u*)(op + 8 * i) = w; }
    }
    __syncthreads();
}
__device__ __forceinline__ void attn_phase(const Args& A, Frame& F, int l) {
    const bf16* u = (const bf16*)(F.ws + WS_U); bf16* mix = (bf16*)(F.ws + WS_MIX);
    const float lam = ((const float*)(F.ws + WS_MISC + MISC_LAM))[l];
    const float lam_init = 0.8f - 0.6f * expf(-0.3f * (float)l);
    const int bh = F.vcu >> 1, pb = (F.vcu & 1) * 4;
    for (int i = 0; i < 4; ++i) {
        const int p = pb + i;
        attn_unit(F, u, mix, bh >> 2, bh & 3, 15 - p, lam, 1.0f - lam_init, A.in[10] + l * 128);
        attn_unit(F, u, mix, bh >> 2, bh & 3, p, lam, 1.0f - lam_init, A.in[10] + l * 128);
    }
}

__device__ __forceinline__ void hgrn_phase(const Args& A, Frame& F, int l) {
    const bf16* u = (const bf16*)(F.ws + WS_U); float* rawo = (float*)(F.ws + WS_RAWO);
    const float* lbl = (const float*)(F.ws + WS_MISC + MISC_LB) + l * 256;
    const int bh = F.vcu >> 1, vhalf = F.vcu & 1, b = bh >> 2, h = bh & 3;
    const int tid = F.tid, lane = F.lane, wid = F.wave;
    LAS unsigned char* lds = F.lds;
    const int tl = tid >> 3, c8 = tid & 7;
    const bf16* zq_p = u + ((size_t)b * SEQ + tl) * DIN + BQ + h * 64 + c8 * 8;
    const bf16* zf_p = u + ((size_t)b * SEQ + tl) * DIN + BF + h * 64 + c8 * 8;
    const bf16* vi_p = u + ((size_t)b * SEQ + tl) * DIN + BI + h * 64 + vhalf * 32 + c8 * 4;
    float lbv[8];
#pragma unroll
    for (int j = 0; j < 8; ++j) lbv[j] = lbl[h * 64 + c8 * 8 + j];
    v4u rq, rf; v2u rv;
#define HG_LOAD(c) do { const size_t go = (size_t)(c) * 64 * DIN; rq = *(const GAS v4u*)(zq_p + go); rf = *(const GAS v4u*)(zf_p + go); rv = *(const GAS v2u*)(vi_p + go); } while (0)
#define HG_STORE(s) do { LAS float* Fs = (LAS float*)(lds + (s) * 40960) + tl * 64 + c8 * 8; LAS float* Qs = Fs + 4096; LAS float* Vs = (LAS float*)(lds + (s) * 40960 + 32768) + tl * 32 + c8 * 4; \
        const unsigned qw[4] = {rq.x, rq.y, rq.z, rq.w}, fw[4] = {rf.x, rf.y, rf.z, rf.w}; float qv[8], fv[8]; \
        _Pragma("unroll") for (int j = 0; j < 4; ++j) { const float z0 = bflo(qw[j]), z1 = bfhi(qw[j]); qv[2 * j] = z0 * fsigmoid(z0); qv[2 * j + 1] = z1 * fsigmoid(z1); \
            const float y0 = bflo(fw[j]), y1 = bfhi(fw[j]); fv[2 * j] = lbv[2 * j] + (1.0f - lbv[2 * j]) * fsigmoid(y0); fv[2 * j + 1] = lbv[2 * j + 1] + (1.0f - lbv[2 * j + 1]) * fsigmoid(y1); } \
        *(LAS f32x4*)(Fs) = (f32x4){fv[0], fv[1], fv[2], fv[3]}; *(LAS f32x4*)(Fs + 4) = (f32x4){fv[4], fv[5], fv[6], fv[7]}; \
        *(LAS f32x4*)(Qs) = (f32x4){qv[0], qv[1], qv[2], qv[3]}; *(LAS f32x4*)(Qs + 4) = (f32x4){qv[4], qv[5], qv[6], qv[7]}; \
        *(LAS f32x4*)(Vs) = (f32x4){bflo(rv.x), bfhi(rv.x), bflo(rv.y), bfhi(rv.y)}; } while (0)
    const int vl = lane >> 4, dg = lane & 15, vv = 4 * wid + vl;
    float S0 = 0.f, S1 = 0.f, S2 = 0.f, S3 = 0.f;
    HG_LOAD(0); HG_STORE(0); __syncthreads();
    for (int c = 0; c < SEQ / 64; ++c) {
        const int s = c & 1;
        if (c + 1 < SEQ / 64) HG_LOAD(c + 1);
        const LAS float* Fs = (const LAS float*)(lds + s * 40960) + 4 * dg; const LAS float* Qs = Fs + 4096; const LAS float* Vs = (const LAS float*)(lds + s * 40960 + 32768) + vv;
        LAS float* OB = (LAS float*)(lds + 81920 + s * 8192);
#pragma unroll 4
        for (int t = 0; t < 64; ++t) {
            const f32x4 f4 = *(const LAS f32x4*)(Fs + t * 64), q4 = *(const LAS f32x4*)(Qs + t * 64); const float v = Vs[t * 32];
            S0 = f4.x * (S0 - v) + v; S1 = f4.y * (S1 - v) + v; S2 = f4.z * (S2 - v) + v; S3 = f4.w * (S3 - v) + v;
            float part = (q4.x * S0 + q4.y * S1) + (q4.z * S2 + q4.w * S3);
            part += __shfl_xor(part, 1); part += __shfl_xor(part, 2); part += __shfl_xor(part, 4); part += __shfl_xor(part, 8);
            if (dg == 0) OB[t * 32 + vv] = part;
        }
        if (c + 1 < SEQ / 64) HG_STORE(s ^ 1);
        __syncthreads();
        *(GAS f32x4*)(rawo + ((size_t)b * SEQ + 64 * c + tl) * 256 + h * 64 + vhalf * 32 + c8 * 4) = *(const LAS f32x4*)(OB + tl * 32 + c8 * 4);
    }
    __syncthreads();
#undef HG_LOAD
#undef HG_STORE
}
__device__ __forceinline__ void hgrn_post_phase(const Args& A, Frame& F, int l) {
    const int gw = F.vcu * 8 + F.wave, NGW = F.G * 8, lane = F.lane;
    const bf16* u = (const bf16*)(F.ws + WS_U); bf16* mix = (bf16*)(F.ws + WS_MIX); const float* rawo = (const float*)(F.ws + WS_RAWO);
    const f32x4 ng = *(const f32x4*)(A.in[12] + l * 64 + (lane & 15) * 4);
    for (int m = gw; m < M; m += NGW) {
        const f32x4 o = *(const GAS f32x4*)(rawo + (size_t)m * 256 + 4 * lane);
        float ss = (o.x * o.x + o.y * o.y) + (o.z * o.z + o.w * o.w);
        ss += __shfl_xor(ss, 1); ss += __shfl_xor(ss, 2); ss += __shfl_xor(ss, 4); ss += __shfl_xor(ss, 8);
        const float rstd = 1.0f / sqrtf(ss * (1.f / 64.f) + EPS);
        const v2u zg = *(const GAS v2u*)(u + (size_t)m * DIN + BG + 4 * lane);
        const float z0 = bflo(zg.x), z1 = bfhi(zg.x), z2 = bflo(zg.y), z3 = bfhi(zg.y);
        v2u w; w.x = pk2(o.x * rstd * ng.x * z0 * fsigmoid(z0), o.y * rstd * ng.y * z1 * fsigmoid(z1)); w.y = pk2(o.z * rstd * ng.z * z2 * fsigmoid(z2), o.w * rstd * ng.w * z3 * fsigmoid(z3));
        *(GAS v2u*)(mix + (size_t)m * D + 512 + 4 * lane) = w;
    }
}

__device__ __forceinline__ void route_phase(const Args& A, Frame& F, int l) {
    const int lane = F.lane, tid = F.tid, wid = F.wave;
    const float* xres = F.out; bf16* XN = (bf16*)(F.ws + WS_XN);
    const float* WrT = (const float*)(F.ws + WS_MISC + MISC_WRT) + (size_t)l * 36 * 1024;
    const float* gffn = A.in[15] + l * D;
    int* tokpos = (int*)(F.ws + WS_MISC + MISC_TOKPOS); float* tokgate = (float*)(F.ws + WS_MISC + MISC_TOKGATE);
    LAS int* lcnt = (LAS int*)(F.lds);
    LAS int* lbase = lcnt + 32;
    LAS int* asg = lcnt + 64;
    if (tid < 32) lcnt[tid] = 0;
    __syncthreads();
    const float biasv = (lane < 32) ? A.in[19][l * 32 + lane] : (lane < 36 ? A.in[17][l * 4 + (lane - 32)] : 0.f);
    const int tb = F.vcu * 256 + wid * 32;
    for (int grp = 0; grp < 8; ++grp) {
        float hv[4][16]; float mylogit[4];
#pragma unroll
        for (int tt = 0; tt < 4; ++tt) {
            const int m = tb + grp * 4 + tt;
            const GAS f32x4* xr = (const GAS f32x4*)(xres + (size_t)m * D) + lane; const GAS f32x4* gr = (const GAS f32x4*)gffn + lane;
            f32x4 v[4]; float s = 0.f;
#pragma unroll
            for (int j = 0; j < 4; ++j) { v[j] = xr[64 * j]; s += (v[j].x * v[j].x + v[j].y * v[j].y) + (v[j].z * v[j].z + v[j].w * v[j].w); }
            const float rstd = 1.0f / sqrtf(wave_sum(s) * (1.f / D) + EPS);
            GAS unsigned long long* o8 = (GAS unsigned long long*)(XN + (size_t)m * D) + lane;
#pragma unroll
            for (int j = 0; j < 4; ++j) { const f32x4 gg = gr[64 * j]; const f32x4 hh = v[j] * rstd * gg;
                hv[tt][4 * j] = hh.x; hv[tt][4 * j + 1] = hh.y; hv[tt][4 * j + 2] = hh.z; hv[tt][4 * j + 3] = hh.w;
                o8[64 * j] = (unsigned long long)pk2(hh.x, hh.y) | ((unsigned long long)pk2(hh.z, hh.w) << 32); }
            mylogit[tt] = 0.f;
        }
#pragma unroll 1
        for (int o = 0; o < 36; ++o) {
            const GAS f32x4* wr_ = (const GAS f32x4*)(WrT + (size_t)o * 1024) + lane;
            f32x4 w[4];
#pragma unroll
            for (int j = 0; j < 4; ++j) w[j] = wr_[64 * j];
#pragma unroll
            for (int tt = 0; tt < 4; ++tt) {
                float a = 0.f;
#pragma unroll
                for (int j = 0; j < 4; ++j) a += (hv[tt][4 * j] * w[j].x + hv[tt][4 * j + 1] * w[j].y) + (hv[tt][4 * j + 2] * w[j].z + hv[tt][4 * j + 3] * w[j].w);
                a = wave_sum(a);
                if (lane == o) mylogit[tt] = a;
            }
        }
#pragma unroll
        for (int tt = 0; tt < 4; ++tt) {
            const int m = tb + grp * 4 + tt; const float lg = mylogit[tt] + biasv;
            float gl[4];
#pragma unroll
            for (int j = 0; j < 4; ++j) gl[j] = __shfl(lg, 32 + j);
            int g = 0; float gm = gl[0];
#pragma unroll
            for (int j = 1; j < 4; ++j) if (gl[j] > gm) { gm = gl[j]; g = j; }
            float den = 0.f;
#pragma unroll
            for (int j = 0; j < 4; ++j) den += expf(gl[j] - gm);
            const float pg = 1.0f / den;
            float ev[8];
#pragma unroll
            for (int j = 0; j < 8; ++j) ev[j] = __shfl(lg, 8 * g + j);
            int i1 = 0; float v1 = ev[0];
#pragma unroll
            for (int j = 1; j < 8; ++j) if (ev[j] > v1) { v1 = ev[j]; i1 = j; }
            int i2 = -1; float v2 = -3.0e38f;
#pragma unroll
            for (int j = 0; j < 8; ++j) if (j != i1 && ev[j] > v2) { v2 = ev[j]; i2 = j; }
            const float e21 = expf(v2 - v1), w1 = 1.0f / (1.0f + e21), w2 = e21 * w1;
            if (lane == 0) {
                const int e1 = 8 * g + i1, e2 = 8 * g + i2;
                const int lp1 = atomicAdd((int*)&lcnt[e1], 1), lp2 = atomicAdd((int*)&lcnt[e2], 1);
                const int tl_ = wid * 32 + grp * 4 + tt;
                asg[tl_ * 2] = (e1 << 16) | lp1; asg[tl_ * 2 + 1] = (e2 << 16) | lp2;
                tokgate[(size_t)m * 2] = pg * w1; tokgate[(size_t)m * 2 + 1] = pg * w2;
            }
        }
    }
    __syncthreads();
    if (tid < 32) lbase[tid] = (int)__hip_atomic_fetch_add((unsigned*)(F.ctl + CW_CNT + l * 32 + tid), (unsigned)lcnt[tid], RLX_AGENT);
    __syncthreads();
    { const int a = asg[tid]; const int e = a >> 16, lp = a & 0xffff; tokpos[(size_t)(F.vcu * 256) * 2 + tid] = (e << 16) | (lbase[e] + lp); }
    __syncthreads();
}
__device__ __forceinline__ void moe_tables(Frame& F, int l) {
    LAS int* ts = (LAS int*)(F.lds + TAB_OFF); LAS int* ut = (LAS int*)(F.lds + TAB_OFF + 256);
    __syncthreads();
    if (F.tid == 0) { int acc = 0;
        for (int e = 0; e < 32; ++e) { ts[e] = acc; acc += ((int)__hip_atomic_load((unsigned*)(F.ctl + CW_CNT + l * 32 + e), RLX_AGENT) + 255) >> 8; }
        ts[32] = acc; }
    __syncthreads();
    if (F.tid < 16) { const int L = F.tid * F.G + F.vcu; int p = -1;
        if (L < 4 * ts[32]) { const int rt = L >> 2; int e = 0; for (int j = 1; j < 32; ++j) e += (ts[j] <= rt) ? 1 : 0; p = (e << 24) | L; }
        ut[F.tid] = p; }
    __syncthreads();
}
__device__ __forceinline__ void gather_phase(Frame& F, int l) {
    moe_tables(F, l);
    const LAS int* ts = (const LAS int*)(F.lds + TAB_OFF);
    const int gw = F.vcu * 8 + F.wave, NGW = F.G * 8, lane = F.lane;
    const bf16* XN = (const bf16*)(F.ws + WS_XN); bf16* Xg = (bf16*)(F.ws + WS_XG);
    const int* tokpos = (const int*)(F.ws + WS_MISC + MISC_TOKPOS); int* tokslot = (int*)(F.ws + WS_MISC + MISC_TOKSLOT);
    for (int m = gw; m < M; m += NGW) {
        const v4u a = *(const GAS v4u*)(XN + (size_t)m * D + 8 * lane), b = *(const GAS v4u*)(XN + (size_t)m * D + 512 + 8 * lane);
#pragma unroll
        for (int k = 0; k < 2; ++k) { const int tp = tokpos[(size_t)m * 2 + k]; const int e = tp >> 16, pos = tp & 0xffff; const int slot = ts[e] * 256 + pos;
            *(GAS v4u*)(Xg + (size_t)slot * D + 8 * lane) = a; *(GAS v4u*)(Xg + (size_t)slot * D + 512 + 8 * lane) = b;
            if (lane == 0) tokslot[(size_t)m * 2 + k] = slot; }
    }
}
__device__ __forceinline__ void combine_phase(const Args& A, Frame& F, int l) {
    const int gw = F.vcu * 8 + F.wave, NGW = F.G * 8, lane = F.lane;
    float* xres = F.out; const bf16* Y = (const bf16*)(F.ws + WS_XG); bf16* XN = (bf16*)(F.ws + WS_XN);
    const int* tokslot = (const int*)(F.ws + WS_MISC + MISC_TOKSLOT); const float* tokgate = (const float*)(F.ws + WS_MISC + MISC_TOKGATE);
    const bool donorm = (l + 1 < DEPTH); const float* gn = A.in[2] + (l + 1 < DEPTH ? (l + 1) * D : 0);
    for (int m = gw; m < M; m += NGW) {
        const int s0 = tokslot[(size_t)m * 2], s1 = tokslot[(size_t)m * 2 + 1]; const float g0 = tokgate[(size_t)m * 2], g1 = tokgate[(size_t)m * 2 + 1];
        GAS f32x4* xr = (GAS f32x4*)(xres + (size_t)m * D) + lane;
        const GAS v2u* y0 = (const GAS v2u*)(Y + (size_t)s0 * D) + lane; const GAS v2u* y1 = (const GAS v2u*)(Y + (size_t)s1 * D) + lane;
        f32x4 v[4]; float s = 0.f;
#pragma unroll
        for (int j = 0; j < 4; ++j) { v[j] = xr[64 * j]; const v2u a = y0[64 * j], b = y1[64 * j];
            v[j].x += g0 * bflo(a.x) + g1 * bflo(b.x); v[j].y += g0 * bfhi(a.x) + g1 * bfhi(b.x); v[j].z += g0 * bflo(a.y) + g1 * bflo(b.y); v[j].w += g0 * bfhi(a.y) + g1 * bfhi(b.y);
            xr[64 * j] = v[j]; s += (v[j].x * v[j].x + v[j].y * v[j].y) + (v[j].z * v[j].z + v[j].w * v[j].w); }
        if (donorm) {
            const float rstd = 1.0f / sqrtf(wave_sum(s) * (1.f / D) + EPS);
            const GAS f32x4* gr = (const GAS f32x4*)gn + lane; GAS unsigned long long* o8 = (GAS unsigned long long*)(XN + (size_t)m * D) + lane;
#pragma unroll
            for (int j = 0; j < 4; ++j) { const f32x4 gg = gr[64 * j]; o8[64 * j] = (unsigned long long)pk2(v[j].x * rstd * gg.x, v[j].y * rstd * gg.y) | ((unsigned long long)pk2(v[j].z * rstd * gg.z, v[j].w * rstd * gg.w) << 32); }
        }
    }
}

constexpr int PH_PER_LAYER = 10, N_PHASES = 1 + DEPTH * PH_PER_LAYER;
__global__ void __launch_bounds__(512, 2) mk_fwd(Args args) {
    extern __shared__ __attribute__((aligned(16))) unsigned char lds[];
    Frame F;
    F.lds = (LAS unsigned char*)lds;
    F.MISC = (volatile LAS unsigned*)(F.lds + MISC_OFF);
    F.tid = threadIdx.x; F.lane = F.tid & 63; F.wave = __builtin_amdgcn_readfirstlane(F.tid >> 6);
    F.G = gridDim.x; { const int bx = blockIdx.x; F.vcu = (F.G % 8 == 0) ? (bx % 8) * (F.G / 8) + bx / 8 : bx; }
    F.ws = args.ws; F.out = args.out; F.ctl = (gu32*)(args.ws + WS_CTL);
    for (int u = F.tid; u < (LDS_BYTES - LDSCTL_OFF) / 4; u += 512) ((LAS unsigned*)(F.lds + LDSCTL_OFF))[u] = 0u;
    __syncthreads();
    const int lo = args.ph_lo, hi = args.ph_hi;
    const bool multi = (hi - lo) > 1;
    XcdBarrier bar; bar.bar = (unsigned*)(F.ctl + CW_BAR); bar.x = 0; bar.st = nullptr;
    if (multi) bar = xcd_barrier_post((unsigned*)(F.ctl + CW_BAR), F.MISC + 8);
#ifndef PHSEL
#define PHSEL(j) true
#endif
#define IN(k) (lo <= (k) && (k) < hi)
#define ENTER() do { int t_ = threadIdx.x; asm volatile("" : "+v"(t_)); F.tid = t_; F.lane = t_ & 63; F.wave = __builtin_amdgcn_readfirstlane(t_ >> 6); } while (0)
#define SEAM(k) do { if (IN(k) && IN((k) + 1)) xcd_barrier(bar); } while (0)
    unsigned char* ws = args.ws;
    if (PHSEL(100) && IN(0)) { ENTER(); p0_prologue(args, F); SEAM(0); }
    for (int l = 0; l < DEPTH; ++l) {
        const int pb = 1 + l * PH_PER_LAYER;
        if (PHSEL(0) && IN(pb + 0)) {
            ENTER();
            pg8::DenseOrder S; S.init(ws + WS_XN, ws + WS_WIN + (size_t)l * DIN * D * 2, M, DIN, D, F.G, (int)blockIdx.x);
            pg8::EpiStoreBf16 E{(bf16*)(ws + WS_U), DIN};
            pg8::gemm_phase<pg8::EpiStoreBf16, pg8::DenseOrder>(F.lds + RING_OFF, D, S, E, F.tid);
            SEAM(pb + 0);
        }
        if (PHSEL(1) && IN(pb + 1)) { ENTER(); prep_phase(args, F, l); SEAM(pb + 1); }
        if (PHSEL(2) && IN(pb + 2)) { ENTER(); hgrn_phase(args, F, l); ENTER(); attn_phase(args, F, l); SEAM(pb + 2); }
        if (PHSEL(3) && IN(pb + 3)) { ENTER(); hgrn_post_phase(args, F, l); SEAM(pb + 3); }
        if (PHSEL(4) && IN(pb + 4)) {
            ENTER();
            pg8::DenseOrder S; S.init(ws + WS_MIX, ws + WS_WOUT + (size_t)l * D * D * 2, M, D, D, F.G, (int)blockIdx.x);
            pg8::EpiResF32 E{l == 0 ? args.in[0] : (const float*)F.out, F.out};
            pg8::gemm_phase<pg8::EpiResF32, pg8::DenseOrder>(F.lds + RING_OFF, D, S, E, F.tid);
            SEAM(pb + 4);
        }
        if (PHSEL(5) && IN(pb + 5)) { ENTER(); route_phase(args, F, l); SEAM(pb + 5); }
        if (PHSEL(6) && IN(pb + 6)) { ENTER(); gather_phase(F, l); SEAM(pb + 6); }
        if (PHSEL(7) && IN(pb + 7)) {
            ENTER();
            moe_tables(F, l);
            pg8::MoeOrder S{(const char*)(ws + WS_XG), (const char*)(ws + WS_WGU + (size_t)l * 32 * D * D * 2), D, (size_t)D * D * 2, (unsigned)(uintptr_t)(F.lds + TAB_OFF + 256), 128};
            pg8::EpiSwiGLU E{(bf16*)(ws + WS_ACT)};
            pg8::gemm_phase<pg8::EpiSwiGLU, pg8::MoeOrder>(F.lds + RING_OFF, D, S, E, F.tid);
            SEAM(pb + 7);
        }
        if (PHSEL(8) && IN(pb + 8)) {
            ENTER();
            moe_tables(F, l);
            pg8::MoeOrder S{(const char*)(ws + WS_ACT), (const char*)(ws + WS_WD + (size_t)l * 32 * D * DEXP * 2), DEXP, (size_t)D * DEXP * 2, (unsigned)(uintptr_t)(F.lds + TAB_OFF + 256), 256};
            pg8::EpiStoreBf16 E{(bf16*)(ws + WS_XG), D};
            pg8::gemm_phase<pg8::EpiStoreBf16, pg8::MoeOrder>(F.lds + RING_OFF, DEXP, S, E, F.tid);
            SEAM(pb + 8);
        }
        if (PHSEL(9) && IN(pb + 9)) { ENTER(); combine_phase(args, F, l); SEAM(pb + 9); }
    }
#undef IN
#undef SEAM
}

extern "C" void kernel_launch(void* const* d_in, const int* in_sizes, int n_in, void* d_out, int out_size, void* d_ws, size_t ws_size, hipStream_t stream) {
    static int grid = 0;
    if (grid == 0) {
        if (n_in != 23 || in_sizes[0] != M * D || out_size != M * D || ws_size < WS_END) { fprintf(stderr, "kernel_launch: unexpected shapes (n_in %d, in0 %d, out %d, ws %zu < %zu); nothing launched\n", n_in, n_in > 0 ? in_sizes[0] : -1, out_size, ws_size, (size_t)WS_END); grid = -1; return; }
        int dev = 0, cus = 0, per_cu = 0;
        if (hipGetDevice(&dev) != hipSuccess || hipDeviceGetAttribute(&cus, hipDeviceAttributeMultiprocessorCount, dev) != hipSuccess) { grid = -1; return; }
        if (hipFuncSetAttribute((const void*)mk_fwd, hipFuncAttributeMaxDynamicSharedMemorySize, LDS_BYTES) != hipSuccess) { fprintf(stderr, "kernel_launch: hipFuncSetAttribute failed\n"); grid = -1; return; }
        if (hipOccupancyMaxActiveBlocksPerMultiprocessor(&per_cu, (const void*)mk_fwd, 512, LDS_BYTES) != hipSuccess || per_cu < 1) { fprintf(stderr, "kernel_launch: occupancy query reports %d\n", per_cu); }
        (void)hipGetLastError();
        grid = cus;
        if (grid != 256) { fprintf(stderr, "kernel_launch: built for 256 CUs, device has %d\n", grid); grid = -1; return; }
    }
    if (grid < 0) return;
    if (hipMemsetAsync((char*)d_ws + WS_CTL, 0, CTL_ZERO_BYTES, stream) != hipSuccess) return;
    Args a{};
    for (int i = 0; i < 23; ++i) a.in[i] = (const float*)d_in[i];
    a.out = (float*)d_out; a.ws = (unsigned char*)d_ws;
    if (MK_N_LAUNCHES == 1) {
        a.ph_lo = 0; a.ph_hi = N_PHASES;
        hipLaunchKernelGGL(mk_fwd, dim3(grid), dim3(512), LDS_BYTES, stream, a);
    } else {
        for (int p = 0; p < N_PHASES; ++p) { a.ph_lo = p; a.ph_hi = p + 1; hipLaunchKernelGGL(mk_fwd, dim3(grid), dim3(512), LDS_BYTES, stream, a); }
    }
}
```

```cpp
#include <hip/hip_runtime.h>
#include <hip/hip_bf16.h>
#include <cstdio>
#include <cstdint>

#define LAS __attribute__((address_space(3)))
#define GAS __attribute__((address_space(1)))

#ifndef MK_N_LAUNCHES
#define MK_N_LAUNCHES 1
#endif

constexpr int D = 1024, BATCH = 32, SEQ = 2048, M = BATCH * SEQ, DEPTH = 2;
constexpr int DIN = 3328, NEXP = 32, DEXP = 512;
constexpr int CAP = 2 * M + NEXP * 256;
constexpr int AQ = 0, AK = 512, AV = 1024, BQ = 1536, BF = 1792, BI = 2048, BG = 2304, CB = 2560, CC = 2816, CX = 3072;
constexpr float EPS = 1e-6f;
constexpr float QSCALE = 0.125f * 1.4426950408889634f;

namespace pg8 {
typedef unsigned short bf16_t;
typedef short bf16x8 __attribute__((ext_vector_type(8)));
typedef float f32x4 __attribute__((ext_vector_type(4)));
typedef unsigned u32x4 __attribute__((ext_vector_type(4)));
constexpr int BM = 256, BK = 64, HALF = 128, HTB = HALF * BK * 2, STAGE_BYTES = 8 * HTB, NXCD = 8, WGM = 8;

__host__ __device__ __forceinline__ int lds_byte(int r, int c) { const int st = (r >> 4) * 2 + (c >> 5), rr = r & 15, cc = c & 31, ob = rr * 64 + cc * 2; return st * 1024 + (ob ^ (((ob >> 9) & 1) << 5)); }
__host__ __device__ __forceinline__ void stage_rc(int b, int& R, int& C) { const int st = b / 1024, sb = b % 1024, swz = sb ^ (((sb >> 9) & 1) << 5); R = (st >> 1) * 16 + swz / 64; C = (st & 1) * 32 + (swz % 64) / 2; }
__host__ __device__ __forceinline__ int perm32(int rho) { const int n = rho >> 4, i = rho & 15; return 8 * (i >> 2) + 4 * n + (i & 3); }

struct Unit { const char* A; const char* B; int row0; int col0; };

struct DenseOrder {
    const char* A; const char* Bt; int K; int nM, nN, nwg, G, c;
    __device__ void init(const void* A_, const void* Bt_, int M_, int N_, int K_, int G_, int c_) { A = (const char*)A_; Bt = (const char*)Bt_; K = K_; nM = M_ / BM; nN = N_ / BM; nwg = nM * nN; G = G_; c = c_; }
    __device__ bool next(int i, Unit& u) const {
        const long L = (long)i * G + c; if (L >= nwg) return false;
        int wgid = (int)L; { const int q = nwg / NXCD, r = nwg % NXCD, xcd = wgid % NXCD, off = wgid / NXCD; wgid = (xcd < r ? xcd * (q + 1) : r * (q + 1) + (xcd - r) * q) + off; }
        const int nig = WGM * nN, gid = wgid / nig, fm = gid * WGM, gsz = (nM - fm) < WGM ? (nM - fm) : WGM;
        const int pm = fm + ((wgid % nig) % gsz), pn = (wgid % nig) / gsz;
        u.A = A + (size_t)pm * BM * K * 2; u.B = Bt + (size_t)pn * BM * K * 2; u.row0 = pm * BM; u.col0 = pn * BM; return true;
    }
};
__device__ __forceinline__ int lds_ld_asm(unsigned addr) { int v; asm volatile("ds_read_b32 %0, %1\n\ts_waitcnt lgkmcnt(0)" : "=&v"(v) : "v"(addr) : "memory"); return v; }
struct MoeOrder {
    const char* A; const char* W; int K; size_t wstride; unsigned tab; int colw;
    __device__ bool next(int i, Unit& u) const {
        if (i >= 16) return false;
        const int p = __builtin_amdgcn_readfirstlane(lds_ld_asm(tab + 4u * (unsigned)i));
        if (p < 0) return false;
        const int e = p >> 24, L = p & 0xffffff, rt = L >> 2, pn = L & 3;
        u.A = A + (size_t)rt * BM * K * 2; u.B = W + (size_t)e * wstride + (size_t)pn * BM * K * 2; u.row0 = rt * BM; u.col0 = pn * colw; return true;
    }
};

__device__ __forceinline__ unsigned cvt_pk_bf16(float lo, float hi) { unsigned r; asm volatile("v_cvt_pk_bf16_f32 %0, %1, %2" : "=v"(r) : "v"(lo), "v"(hi)); return r; }

struct EpiStoreBf16 {
    static constexpr bool PERM = true;
    bf16_t* O; int ldc;
    __device__ __forceinline__ void operator()(const f32x4 (&acc)[2][2][4][2], const Unit& u, int wr, int wc, int fr, int fq) const {
        const int row0 = u.row0 + wr * 64 + fr, col0 = u.col0 + wc * 32 + 8 * fq;
#pragma unroll
        for (int ai = 0; ai < 2; ++ai)
#pragma unroll
            for (int m = 0; m < 4; ++m) { bf16_t* rowp = O + (size_t)(row0 + ai * HALF + m * 16) * ldc + col0;
#pragma unroll
                for (int bj = 0; bj < 2; ++bj) { const f32x4 v0 = acc[ai][bj][m][0], v1 = acc[ai][bj][m][1];
                    u32x4 w; w.x = cvt_pk_bf16(v0[0], v0[1]); w.y = cvt_pk_bf16(v0[2], v0[3]); w.z = cvt_pk_bf16(v1[0], v1[1]); w.w = cvt_pk_bf16(v1[2], v1[3]);
                    *(u32x4*)(rowp + bj * HALF) = w; } }
    }
};
struct EpiSwiGLU {
    static constexpr bool PERM = true;
    bf16_t* O;
    __device__ __forceinline__ void operator()(const f32x4 (&acc)[2][2][4][2], const Unit& u, int wr, int wc, int fr, int fq) const {
        const int row0 = u.row0 + wr * 64 + fr, col0 = u.col0 + wc * 32 + 8 * fq;
#pragma unroll
        for (int ai = 0; ai < 2; ++ai)
#pragma unroll
            for (int m = 0; m < 4; ++m) { bf16_t* rowp = O + (size_t)(row0 + ai * HALF + m * 16) * DEXP + col0;
                float a[8];
#pragma unroll
                for (int n = 0; n < 2; ++n)
#pragma unroll
                    for (int j = 0; j < 4; ++j) { const float g = acc[ai][0][m][n][j], up = acc[ai][1][m][n][j];
                        a[n * 4 + j] = g * __builtin_amdgcn_rcpf(1.0f + __builtin_amdgcn_exp2f(-1.4426950408889634f * g)) * up; }
                u32x4 w; w.x = cvt_pk_bf16(a[0], a[1]); w.y = cvt_pk_bf16(a[2], a[3]); w.z = cvt_pk_bf16(a[4], a[5]); w.w = cvt_pk_bf16(a[6], a[7]);
                *(u32x4*)rowp = w; }
    }
};
struct EpiResF32 {
    static constexpr bool PERM = false;
    const float* base; float* out;
    __device__ __forceinline__ void operator()(const f32x4 (&acc)[2][2][4][2], const Unit& u, int wr, int wc, int fr, int fq) const {
        const int row0 = u.row0 + wr * 64 + fr, col0 = u.col0 + wc * 32 + 4 * fq;
#pragma unroll
        for (int ai = 0; ai < 2; ++ai)
#pragma unroll
            for (int m = 0; m < 4; ++m) { const size_t off = (size_t)(row0 + ai * HALF + m * 16) * D + col0;
#pragma unroll
                for (int bj = 0; bj < 2; ++bj)
#pragma unroll
                    for (int n = 0; n < 2; ++n) { const f32x4 bs = *(const f32x4*)(base + off + bj * HALF + n * 16); *(f32x4*)(out + off + bj * HALF + n * 16) = bs + acc[ai][bj][m][n]; } }
    }
};

template <class Epi, class Sched, bool ALIGN_EPI = true>
__device__ __forceinline__ void gemm_phase(LAS unsigned char* lds, const int K, const Sched& S, const Epi& E, const int tid) {
    const int wid = __builtin_amdgcn_readfirstlane(tid >> 6), lane = tid & 63, wr = wid >> 2, wc = wid & 3, fr = lane & 15, fq = lane >> 4;
    const int nt = K / BK;
    unsigned voffA[2], voffB[2];
#pragma unroll
    for (int i = 0; i < 2; ++i) { int R, C; stage_rc(tid * 16 + i * 8192, R, C); const int Rb = Epi::PERM ? ((R & ~31) + perm32(R & 31)) : R;
        voffA[i] = (unsigned)(R * K + C) * 2u; voffB[i] = (unsigned)(Rb * K + C) * 2u; }
    const size_t kstep = (size_t)(BK * 2);
    const size_t hstep = (size_t)HALF * K * 2;
    const unsigned ldsw = (unsigned)wid * 1024u;
    const int aoff = lds_byte(wr * 64 + fr, fq * 8), boff = lds_byte(wc * 32 + fr, fq * 8);
#define PG8_SA(b, h) (((b) * 2 + (h)) * HTB)
#define PG8_SB(b, h) ((4 + (b) * 2 + (h)) * HTB)
#define PG8_STAGE(bufoff, gbase, voff) do { _Pragma("unroll") for (int _i = 0; _i < 2; ++_i) \
        __builtin_amdgcn_global_load_lds((const unsigned*)((const char*)(gbase) + (voff)[_i]), (LAS unsigned*)(lds + (bufoff) + ldsw + _i * 8192), 16, 0, 0); } while (0)
#define PG8_LDA(dst, b, h) do { _Pragma("unroll") for (int m = 0; m < 4; ++m) _Pragma("unroll") for (int k = 0; k < 2; ++k) dst[m][k] = *(const LAS bf16x8*)(lds + PG8_SA(b, h) + aoff + m * 2048 + k * 1024); } while (0)
#define PG8_LDB(dst, b, h) do { _Pragma("unroll") for (int n = 0; n < 2; ++n) _Pragma("unroll") for (int k = 0; k < 2; ++k) dst[n][k] = *(const LAS bf16x8*)(lds + PG8_SB(b, h) + boff + n * 2048 + k * 1024); } while (0)
#define PG8_MMA(ai, bj, At, Bt) do { __builtin_amdgcn_s_setprio(1); _Pragma("unroll") for (int m = 0; m < 4; ++m) _Pragma("unroll") for (int n = 0; n < 2; ++n) _Pragma("unroll") for (int k = 0; k < 2; ++k) \
        acc[ai][bj][m][n] = __builtin_amdgcn_mfma_f32_16x16x32_bf16(Bt[n][k], At[m][k], acc[ai][bj][m][n], 0, 0, 0); __builtin_amdgcn_s_setprio(0); } while (0)
#define PG8_WAIT_V(n) asm volatile("s_waitcnt vmcnt(" #n ")" ::: "memory")
#define PG8_WAIT_L(n) asm volatile("s_waitcnt lgkmcnt(" #n ")" ::: "memory")
#define PG8_BAR __builtin_amdgcn_s_barrier()
#define PG8_SCHED __builtin_amdgcn_sched_barrier(0)
    Unit cur, nxt; int ui = 0;
    if (!S.next(0, cur)) return;
    f32x4 acc[2][2][4][2];
#pragma unroll
    for (int a = 0; a < 2; ++a)
#pragma unroll
        for (int b = 0; b < 2; ++b)
#pragma unroll
            for (int m = 0; m < 4; ++m)
#pragma unroll
                for (int n = 0; n < 2; ++n) acc[a][b][m][n] = (f32x4){0.f, 0.f, 0.f, 0.f};
    bf16x8 At[4][2], B0[2][2], B1[2][2];
    const char* cA = cur.A; const char* cB = cur.B;
    PG8_STAGE(PG8_SB(0, 0), cB, voffB); PG8_STAGE(PG8_SB(0, 1), cB + hstep, voffB); PG8_STAGE(PG8_SA(0, 0), cA, voffA); PG8_STAGE(PG8_SA(0, 1), cA + hstep, voffA);
    if (wr == 1) PG8_BAR;
    PG8_WAIT_V(2); PG8_BAR;
    PG8_STAGE(PG8_SB(1, 0), cB + kstep, voffB); PG8_STAGE(PG8_SA(1, 0), cA + kstep, voffA); PG8_STAGE(PG8_SB(1, 1), cB + hstep + kstep, voffB);
    PG8_WAIT_V(6); PG8_BAR;
    for (;;) {
        const bool has_next = S.next(ui + 1, nxt);
        const char* nA = has_next ? nxt.A : cA; const char* nB = has_next ? nxt.B : cB;
        for (int t = 0; t < nt; t += 2) {
            const bool last = (t == nt - 2);
            const char* a1 = cA + (size_t)(t + 1) * kstep;
            const char* a2 = last ? nA : cA + (size_t)(t + 2) * kstep; const char* b2 = last ? nB : cB + (size_t)(t + 2) * kstep;
            const char* a3 = a2 + kstep; const char* b3 = b2 + kstep;
            PG8_LDB(B0, 0, 0); PG8_LDB(B1, 0, 1); PG8_SCHED; PG8_LDA(At, 0, 0); PG8_STAGE(PG8_SA(1, 1), a1 + hstep, voffA);
            PG8_WAIT_V(8); PG8_WAIT_L(0); PG8_BAR; PG8_MMA(0, 0, At, B0); PG8_MMA(0, 1, At, B1); PG8_BAR; PG8_SCHED;
            PG8_LDA(At, 0, 1); PG8_STAGE(PG8_SB(0, 0), b2, voffB); PG8_STAGE(PG8_SB(0, 1), b2 + hstep, voffB); PG8_STAGE(PG8_SA(0, 0), a2, voffA);
            PG8_WAIT_V(8); PG8_WAIT_L(0); PG8_BAR; PG8_MMA(1, 0, At, B0); PG8_MMA(1, 1, At, B1); PG8_BAR; PG8_SCHED;
            PG8_LDB(B0, 1, 0); PG8_LDB(B1, 1, 1); PG8_SCHED; PG8_LDA(At, 1, 0); PG8_STAGE(PG8_SA(0, 1), a2 + hstep, voffA);
            PG8_WAIT_V(8); PG8_WAIT_L(0); PG8_BAR; PG8_MMA(0, 0, At, B0); PG8_MMA(0, 1, At, B1); PG8_BAR; PG8_SCHED;
            PG8_LDA(At, 1, 1); PG8_STAGE(PG8_SB(1, 0), b3, voffB); PG8_STAGE(PG8_SB(1, 1), b3 + hstep, voffB); PG8_STAGE(PG8_SA(1, 0), a3, voffA);
            PG8_WAIT_V(8); PG8_WAIT_L(0); PG8_BAR; PG8_MMA(1, 0, At, B0); PG8_MMA(1, 1, At, B1); PG8_BAR; PG8_SCHED;
        }
        if constexpr (ALIGN_EPI) { if (wr == 0) PG8_BAR; }
        E(acc, cur, wr, wc, fr, fq);
        if (!has_next) break;
#pragma unroll
        for (int a = 0; a < 2; ++a)
#pragma unroll
            for (int b = 0; b < 2; ++b)
#pragma unroll
                for (int m = 0; m < 4; ++m)
#pragma unroll
                    for (int n = 0; n < 2; ++n) acc[a][b][m][n] = (f32x4){0.f, 0.f, 0.f, 0.f};
        cur = nxt; cA = nA; cB = nB; ++ui;
        if constexpr (ALIGN_EPI) { if (wr == 1) PG8_BAR; }
    }
    PG8_WAIT_V(0);
    if constexpr (!ALIGN_EPI) { if (wr == 0) PG8_BAR; }
    PG8_BAR;
#undef PG8_SA
#undef PG8_SB
#undef PG8_STAGE
#undef PG8_LDA
#undef PG8_LDB
#undef PG8_MMA
#undef PG8_WAIT_V
#undef PG8_WAIT_L
#undef PG8_BAR
#undef PG8_SCHED
}
}

constexpr size_t MiB = 1u << 20;
constexpr size_t WS_CTL = 0, CTL_ZERO_BYTES = 1 * MiB;
constexpr size_t WS_MISC = 1 * MiB;
constexpr size_t MISC_LAM = 0;
constexpr size_t MISC_LB = 1024;
constexpr size_t MISC_WRT = 64 * 1024;
constexpr size_t MISC_ROPE = 1 * MiB;
constexpr size_t MISC_TOKPOS = 6 * MiB;
constexpr size_t MISC_TOKGATE = 7 * MiB;
constexpr size_t MISC_TOKSLOT = 8 * MiB;
constexpr size_t WS_WIN = 17 * MiB;
constexpr size_t WS_WOUT = 30 * MiB;
constexpr size_t WS_WGU = 34 * MiB;
constexpr size_t WS_WD = 162 * MiB;
constexpr size_t WS_U = 226 * MiB;
constexpr size_t WS_XG = WS_U, WS_ACT = WS_U + 272 * MiB;
constexpr size_t WS_MIX = 642 * MiB;
constexpr size_t WS_XN = 770 * MiB;
constexpr size_t WS_RAWO = 898 * MiB;
constexpr size_t WS_END = 962 * MiB;
static_assert((size_t)CAP * 1024 * 2 <= 272 * MiB && (size_t)CAP * 512 * 2 <= 136 * MiB && (size_t)M * DIN * 2 <= 416 * MiB, "ws map");
constexpr int CW_BAR = 4096;
constexpr int CW_CNT = 16384;

constexpr int RING_OFF = 0, RING_BYTES = 131072;
constexpr int LDSCTL_OFF = RING_BYTES, MISC_OFF = LDSCTL_OFF + 320;
constexpr int TAB_OFF = LDSCTL_OFF + 1024;
constexpr int LDS_BYTES = 147456;

typedef unsigned short bf16;
typedef unsigned v4u __attribute__((ext_vector_type(4)));
typedef unsigned v2u __attribute__((ext_vector_type(2)));
typedef float f32x4 __attribute__((ext_vector_type(4)));
typedef float f32x16 __attribute__((ext_vector_type(16)));
typedef short bf16x8 __attribute__((ext_vector_type(8)));
typedef short s16x4 __attribute__((ext_vector_type(4)));
typedef GAS unsigned gu32;
#define RLX_AGENT __ATOMIC_RELAXED, __HIP_MEMORY_SCOPE_AGENT
#define LDS_WAIT() asm volatile("s_waitcnt lgkmcnt(0)" ::: "memory")
#define VM_WAIT() asm volatile("s_waitcnt vmcnt(0)" ::: "memory")
typedef float f32x2_t __attribute__((ext_vector_type(2))); typedef __bf16 bf16x2_t __attribute__((ext_vector_type(2)));
__device__ __forceinline__ unsigned pk2(float lo, float hi) { f32x2_t v = {lo, hi}; bf16x2_t b = __builtin_convertvector(v, bf16x2_t); return __builtin_bit_cast(unsigned, b); }
__device__ __forceinline__ float bflo(unsigned w) { return __uint_as_float(w << 16); }
__device__ __forceinline__ float bfhi(unsigned w) { return __uint_as_float(w & 0xffff0000u); }
__device__ __forceinline__ float fsigmoid(float z) { return __builtin_amdgcn_rcpf(1.0f + __builtin_amdgcn_exp2f(-1.4426950408889634f * z)); }

#define XB_TMO      128
#define XB_XCNT(j)  (256  + 64 * (j))
#define XB_XSUB(j)  (1280 + 64 * (j))
#define XB_XGEN(j)  (2304 + 64 * (j))
#define XB_TOP      3328
#define XB_TOPGEN   3392
#define XCD_BAR_WORDS 3456
#define XB_SPIN_CAP (1u << 18)
__device__ __forceinline__ unsigned xb_ld(unsigned* p)              { return __hip_atomic_load(p, __ATOMIC_RELAXED, __HIP_MEMORY_SCOPE_AGENT); }
__device__ __forceinline__ unsigned xb_add(unsigned* p, unsigned v) { return __hip_atomic_fetch_add(p, v, __ATOMIC_RELAXED, __HIP_MEMORY_SCOPE_AGENT); }
__device__ __forceinline__ unsigned xb_xcc_id() { return (unsigned)__builtin_amdgcn_s_getreg((3 << 11) | 20) & 0xFu; }
#define XB_SPIN(cond, bar) do { unsigned _sp = 0; while (cond) { __builtin_amdgcn_s_sleep(1); \
    if ((++_sp & 255u) == 0u) { if (xb_ld(&(bar)[XB_TMO])) break; if (_sp > XB_SPIN_CAP) { atomicAdd(&(bar)[XB_TMO], 1u); break; } } } } while (0)
struct XcdBarrier { unsigned* bar; unsigned x; volatile LAS unsigned* st; };
__device__ __forceinline__ XcdBarrier xcd_barrier_post(unsigned* bar, volatile LAS unsigned* st) {
    XcdBarrier b; b.bar = bar; b.x = xb_xcc_id(); b.st = st;
    if (threadIdx.x == 0) (void)xb_add(&bar[XB_XCNT(b.x)], 1u);
    return b;
}
__device__ __forceinline__ void xcd_barrier_complete(unsigned* bar, unsigned x, unsigned& nloc, unsigned& nx) {
    const unsigned G = gridDim.x * gridDim.y * gridDim.z;
    unsigned sum, cnt, mine, sp = 0u;
    for (;;) {
        sum = 0u; cnt = 0u; mine = 0u;
#pragma unroll
        for (unsigned j = 0; j < 16; ++j) { const unsigned c = xb_ld(&bar[XB_XCNT(j)]); sum += c; cnt += (c > 0u) ? 1u : 0u; mine = (j == x) ? c : mine; }
        if (sum == G) break;
        __builtin_amdgcn_s_sleep(1);
        if ((++sp & 255u) == 0u) { if (xb_ld(&bar[XB_TMO])) break; if (sp > XB_SPIN_CAP) { atomicAdd(&bar[XB_TMO], 1u); break; } }
    }
    nloc = mine > 0u ? mine : 1u; nx = cnt > 0u ? cnt : 1u;
}
__device__ __forceinline__ void xcd_barrier(const XcdBarrier& b) {
    asm volatile("s_waitcnt vmcnt(0)" ::: "memory");
    __syncthreads();
    if (threadIdx.x == 0) {
        unsigned* bar = b.bar;
        __builtin_amdgcn_s_waitcnt(0);
        unsigned nloc = b.st[0], nx = b.st[1];
        if (nloc == 0u) { xcd_barrier_complete(bar, b.x, nloc, nx); b.st[0] = nloc; b.st[1] = nx; }
        const unsigned old = xb_add(&bar[XB_XSUB(b.x)], 1u);
        const unsigned gen = old / nloc;
        if (old + 1u == (gen + 1u) * nloc) {
            __builtin_amdgcn_fence(__ATOMIC_RELEASE, "agent");
            asm volatile("s_waitcnt vmcnt(0)" ::: "memory");
            const unsigned og = xb_add(&bar[XB_TOP], 1u);
            const unsigned tg = og / nx;
            if (og + 1u == (tg + 1u) * nx) xb_add(&bar[XB_TOPGEN], 1u);
            else XB_SPIN(xb_ld(&bar[XB_TOPGEN]) == tg, bar);
            __builtin_amdgcn_fence(__ATOMIC_ACQUIRE, "agent");
            xb_add(&bar[XB_XGEN(b.x)], 1u);
            asm volatile("s_waitcnt vmcnt(0)" ::: "memory");
        } else {
            XB_SPIN(xb_ld(&bar[XB_XGEN(b.x)]) == gen, bar);
            __builtin_amdgcn_fence(__ATOMIC_ACQUIRE, "agent");
            asm volatile("s_waitcnt vmcnt(0)" ::: "memory");
        }
    }
    __syncthreads();
}

struct Args { const float* in[23]; float* out; unsigned char* ws; int ph_lo, ph_hi; };
struct Frame {
    LAS unsigned char* lds;
    volatile LAS unsigned* MISC;
    gu32* ctl;
    int tid, lane, wave;
    int vcu, G;
    float* out; unsigned char* ws;
};
__device__ __forceinline__ float wave_sum(float v) {
#pragma unroll
    for (int o = 1; o < 64; o <<= 1) v += __shfl_xor(v, o);
    return v;
}

__device__ __forceinline__ void p0_transpose_item(const float* W, int K, int N, bf16* WT, int dst_row0, int k0, int n0, LAS float* scr, int lane) {
#pragma unroll 8
    for (int i = 0; i < 32; ++i) { const int kk = 2 * i + (lane >> 5); scr[kk * 33 + (lane & 31)] = W[(size_t)(k0 + kk) * N + n0 + (lane & 31)]; }
    LDS_WAIT(); asm volatile("" ::: "memory");
    const int c = lane & 7;
#pragma unroll
    for (int j = 0; j < 4; ++j) { const int n = (lane >> 3) + 8 * j; const LAS float* s = scr + (8 * c) * 33 + n;
        v4u o; o.x = pk2(s[0 * 33], s[1 * 33]); o.y = pk2(s[2 * 33], s[3 * 33]); o.z = pk2(s[4 * 33], s[5 * 33]); o.w = pk2(s[6 * 33], s[7 * 33]);
        *(GAS v4u*)(WT + (size_t)(dst_row0 + n) * K + k0 + 8 * c) = o; }
    LDS_WAIT(); asm volatile("" ::: "memory");
}
__device__ __forceinline__ void rms_row_to_bf16(const float* xrow, const float* g, bf16* orow, int lane) {
    const GAS f32x4* xr = (const GAS f32x4*)xrow + lane; const GAS f32x4* gr = (const GAS f32x4*)g + lane;
    f32x4 v[4]; float s = 0.f;
#pragma unroll
    for (int j = 0; j < 4; ++j) { v[j] = xr[64 * j]; s += (v[j].x * v[j].x + v[j].y * v[j].y) + (v[j].z * v[j].z + v[j].w * v[j].w); }
    const float rstd = 1.0f / sqrtf(wave_sum(s) * (1.f / D) + EPS);
    GAS unsigned long long* o8 = (GAS unsigned long long*)orow + lane;
#pragma unroll
    for (int j = 0; j < 4; ++j) { const f32x4 gg = gr[64 * j]; o8[64 * j] = (unsigned long long)pk2(v[j].x * rstd * gg.x, v[j].y * rstd * gg.y) | ((unsigned long long)pk2(v[j].z * rstd * gg.z, v[j].w * rstd * gg.w) << 32); }
}
__device__ __forceinline__ void p0_prologue(const Args& A, Frame& F) {
    LAS float* scr = (LAS float*)(F.lds + RING_OFF + F.wave * 16384);
    const int gw = F.vcu * 8 + F.wave, NGW = F.G * 8;
    unsigned char* ws = F.ws;
    constexpr int I_WIN = 16 * 104, I_WOUT = 16 * 32, I_G = 16 * 16, I_D = 8 * 32;
    constexpr int N_WIN = 2 * I_WIN, N_WOUT = 2 * I_WOUT, N_G = 64 * I_G, N_D = 64 * I_D;
    constexpr int NITEMS = N_WIN + N_WOUT + 2 * N_G + N_D;
    for (int it = gw; it < NITEMS; it += NGW) {
        int r = it;
        if (r < N_WIN) { const int l = r / I_WIN, q = r % I_WIN, kb = q / 104, nb = q % 104;
            p0_transpose_item(A.in[3] + (size_t)l * D * DIN, D, DIN, (bf16*)(ws + WS_WIN) + (size_t)l * DIN * D, 32 * nb, 64 * kb, 32 * nb, scr, F.lane); continue; } r -= N_WIN;
        if (r < N_WOUT) { const int l = r / I_WOUT, q = r % I_WOUT, kb = q / 32, nb = q % 32;
            p0_transpose_item(A.in[14] + (size_t)l * D * D, D, D, (bf16*)(ws + WS_WOUT) + (size_t)l * D * D, 32 * nb, 64 * kb, 32 * nb, scr, F.lane); continue; } r -= N_WOUT;
        if (r < N_G) { const int le = r / I_G, q = r % I_G, kb = q / 16, nb = q % 16, n0 = 32 * nb;
            p0_transpose_item(A.in[20] + (size_t)le * D * DEXP, D, DEXP, (bf16*)(ws + WS_WGU) + (size_t)le * D * D, (n0 >> 7) * 256 + (n0 & 127), 64 * kb, n0, scr, F.lane); continue; } r -= N_G;
        if (r < N_G) { const int le = r / I_G, q = r % I_G, kb = q / 16, nb = q % 16, n0 = 32 * nb;
            p0_transpose_item(A.in[21] + (size_t)le * D * DEXP, D, DEXP, (bf16*)(ws + WS_WGU) + (size_t)le * D * D, (n0 >> 7) * 256 + 128 + (n0 & 127), 64 * kb, n0, scr, F.lane); continue; } r -= N_G;
        { const int le = r / I_D, q = r % I_D, kb = q / 32, nb = q % 32;
            p0_transpose_item(A.in[22] + (size_t)le * DEXP * D, DEXP, D, (bf16*)(ws + WS_WD) + (size_t)le * D * DEXP, 32 * nb, 64 * kb, 32 * nb, scr, F.lane); }
    }
    const int gt = F.vcu * 512 + F.tid, NGT = F.G * 512;
    { float* WrT = (float*)(ws + WS_MISC + MISC_WRT);
      for (int i = gt; i < 2 * 36 * 1024; i += NGT) { const int l = i / (36 * 1024), o = (i / 1024) % 36, k = i % 1024;
          WrT[i] = (o < 32) ? A.in[18][((size_t)l * D + k) * 32 + o] : A.in[16][((size_t)l * D + k) * 4 + (o - 32)]; } }
    { float* rope = (float*)(ws + WS_MISC + MISC_ROPE); const int* pos = (const int*)A.in[1];
      for (int i = gt; i < M * 8; i += NGT) { const int m = i >> 3, f = i & 7;
          const float invf = exp2f(-(float)f * (18.931568569324174f / 8.0f));
          const float ang = (float)pos[m] * invf; float sn, cs; sincosf(ang, &sn, &cs);
          rope[(size_t)m * 16 + f] = cs; rope[(size_t)m * 16 + 8 + f] = sn; } }
    if (gt < 2) { const int l = gt; float s1 = 0.f, s2 = 0.f;
        for (int i = 0; i < 64; ++i) { s1 += A.in[6][l * 64 + i] * A.in[7][l * 64 + i]; s2 += A.in[8][l * 64 + i] * A.in[9][l * 64 + i]; }
        const float lam_init = 0.8f - 0.6f * expf(-0.3f * (float)l);
        ((float*)(ws + WS_MISC + MISC_LAM))[l] = expf(s1) - expf(s2) + lam_init; }
    if (gt >= 512 && gt < 512 + 256) { const int j = gt - 512; const float h0 = A.in[11][j], h1 = A.in[11][256 + j];
        float* lb = (float*)(ws + WS_MISC + MISC_LB); lb[j] = 0.f; lb[256 + j] = 1.0f / (1.0f + expf(h0 - h1)); }
    for (int m = gw; m < M; m += NGW) rms_row_to_bf16(A.in[0] + (size_t)m * D, A.in[2], (bf16*)(ws + WS_XN) + (size_t)m * D, F.lane);
}

__device__ __forceinline__ void prep_phase(const Args& A, Frame& F, int l) {
    const int gw = F.vcu * 8 + F.wave, NGW = F.G * 8, lane = F.lane;
    bf16* u = (bf16*)(F.ws + WS_U); bf16* mix = (bf16*)(F.ws + WS_MIX);
    const float* rope = (const float*)(F.ws + WS_MISC + MISC_ROPE);
    const int grp = lane >> 2, sub = lane & 3;
    const float* gsrc = (grp < 8 ? A.in[4] : A.in[5]) + l * 64 + sub * 16;
    float gn[16];
#pragma unroll
    for (int j = 0; j < 16; ++j) gn[j] = gsrc[j] * (grp < 8 ? QSCALE : 1.0f);
    const float* cw = A.in[13] + (size_t)l * 3 * 256 + 4 * lane;
    const f32x4 w0 = *(const f32x4*)(cw), w1 = *(const f32x4*)(cw + 256), w2 = *(const f32x4*)(cw + 512);
    for (int m = gw; m < M; m += NGW) {
        bf16* row = u + (size_t)m * DIN;
        v4u a = *(GAS v4u*)(row + 16 * lane), b = *(GAS v4u*)(row + 16 * lane + 8);
        float v[16];
        v[0] = bflo(a.x); v[1] = bfhi(a.x); v[2] = bflo(a.y); v[3] = bfhi(a.y); v[4] = bflo(a.z); v[5] = bfhi(a.z); v[6] = bflo(a.w); v[7] = bfhi(a.w);
        v[8] = bflo(b.x); v[9] = bfhi(b.x); v[10] = bflo(b.y); v[11] = bfhi(b.y); v[12] = bflo(b.z); v[13] = bfhi(b.z); v[14] = bflo(b.w); v[15] = bfhi(b.w);
        float ss = 0.f;
#pragma unroll
        for (int j = 0; j < 16; ++j) ss += v[j] * v[j];
        ss += __shfl_xor(ss, 1); ss += __shfl_xor(ss, 2);
        const float rstd = 1.0f / sqrtf(ss * (1.f / 64.f) + EPS);
#pragma unroll
        for (int j = 0; j < 16; ++j) v[j] = v[j] * rstd * gn[j];
        if (sub == 0) {
            const f32x4 c0 = *(const f32x4*)(rope + (size_t)m * 16), c1 = *(const f32x4*)(rope + (size_t)m * 16 + 4), s0 = *(const f32x4*)(rope + (size_t)m * 16 + 8), s1 = *(const f32x4*)(rope + (size_t)m * 16 + 12);
            const float cs[8] = {c0.x, c0.y, c0.z, c0.w, c1.x, c1.y, c1.z, c1.w}, sn[8] = {s0.x, s0.y, s0.z, s0.w, s1.x, s1.y, s1.z, s1.w};
#pragma unroll
            for (int i = 0; i < 8; ++i) { const float t1 = v[i], t2 = v[8 + i]; v[i] = t1 * cs[i] - t2 * sn[i]; v[8 + i] = t1 * sn[i] + t2 * cs[i]; }
        }
        a.x = pk2(v[0], v[1]); a.y = pk2(v[2], v[3]); a.z = pk2(v[4], v[5]); a.w = pk2(v[6], v[7]);
        b.x = pk2(v[8], v[9]); b.y = pk2(v[10], v[11]); b.z = pk2(v[12], v[13]); b.w = pk2(v[14], v[15]);
        *(GAS v4u*)(row + 16 * lane) = a; *(GAS v4u*)(row + 16 * lane + 8) = b;
        const int s = m & (SEQ - 1);
        const v2u cbv = *(GAS v2u*)(row + CB + 4 * lane);
        f32x4 h0 = {0.f, 0.f, 0.f, 0.f}, h1 = h0, h2;
        { const v2u c = *(GAS v2u*)(row + CC + 4 * lane), x = *(GAS v2u*)(row + CX + 4 * lane);
          h2 = (f32x4){bflo(c.x) * bflo(x.x), bfhi(c.x) * bfhi(x.x), bflo(c.y) * bflo(x.y), bfhi(c.y) * bfhi(x.y)}; }
        if (s >= 1) { const bf16* r1 = row - DIN; const v2u c = *(GAS v2u*)(r1 + CC + 4 * lane), x = *(GAS v2u*)(r1 + CX + 4 * lane);
          h1 = (f32x4){bflo(c.x) * bflo(x.x), bfhi(c.x) * bfhi(x.x), bflo(c.y) * bflo(x.y), bfhi(c.y) * bfhi(x.y)}; }
        if (s >= 2) { const bf16* r2 = row - 2 * DIN; const v2u c = *(GAS v2u*)(r2 + CC + 4 * lane), x = *(GAS v2u*)(r2 + CX + 4 * lane);
          h0 = (f32x4){bflo(c.x) * bflo(x.x), bfhi(c.x) * bfhi(x.x), bflo(c.y) * bflo(x.y), bfhi(c.y) * bfhi(x.y)}; }
        const f32x4 cbf = {bflo(cbv.x), bfhi(cbv.x), bflo(cbv.y), bfhi(cbv.y)};
        const f32x4 y = cbf * (w0 * h0 + w1 * h1 + w2 * h2);
        v2u o; o.x = pk2(y.x, y.y); o.y = pk2(y.z, y.w);
        *(GAS v2u*)(mix + (size_t)m * D + 768 + 4 * lane) = o;
    }
}

__device__ __forceinline__ int crow(int r, int hi) { return (r & 3) + 8 * (r >> 2) + 4 * hi; }
typedef short v4i16_t __attribute__((ext_vector_type(4)));
__device__ __forceinline__ s16x4 vtr(const LAS unsigned char* p) { return __builtin_bit_cast(s16x4, __builtin_amdgcn_ds_read_tr16_b64_v4i16((LAS v4i16_t*)p)); }
constexpr int XS = 132;
__device__ __forceinline__ void attn_unit(Frame& F, const bf16* u, bf16* mix, int b, int h, int rb, float lam, float oscale, const float* subg) {
    const int lane = F.lane, r32 = lane & 31, hi = lane >> 5, wid = F.wave, rg = wid & 3, comp = wid >> 2;
    const size_t rowb = (size_t)b * SEQ; const int t0 = rb * 128;
    const int NT = 2 * rb + 2, ntw = 2 * rb + (rg >> 1) + 1;
    LAS unsigned char* lds = F.lds;
    const bf16* ksrc0 = u + (rowb + lane) * DIN + AK + h * 128 + wid * 8;
    const bf16* ksrc1 = ksrc0 + 64;
    const bf16* vsrcA = u + (rowb + 32 * (wid & 1) + (lane >> 2)) * DIN + AV + h * 128 + (wid >> 1) * 32 + (lane & 3) * 8;
    const bf16* vsrcB = vsrcA + 16 * DIN;
#define ATT_DMA(j, s) do { const size_t go = (size_t)(j) * 64 * DIN; LAS unsigned char* sb = lds + (s) * 32768 + wid * 1024; \
        __builtin_amdgcn_global_load_lds((const unsigned*)(ksrc0 + go), (LAS unsigned*)(sb), 16, 0, 0); \
        __builtin_amdgcn_global_load_lds((const unsigned*)(ksrc1 + go), (LAS unsigned*)(sb + 8192), 16, 0, 0); \
        __builtin_amdgcn_global_load_lds((const unsigned*)(vsrcA + go), (LAS unsigned*)(sb + 16384 + wid * 1024), 16, 0, 0); \
        __builtin_amdgcn_global_load_lds((const unsigned*)(vsrcB + go), (LAS unsigned*)(sb + 16384 + wid * 1024 + 1024), 16, 0, 0); } while (0)
    ATT_DMA(0, 0);
    const bf16* qp = u + (rowb + t0 + 32 * rg + r32) * DIN + AQ + h * 128 + comp * 64 + hi * 8;
    bf16x8 qr[4];
#pragma unroll
    for (int d0 = 0; d0 < 4; ++d0) qr[d0] = *(const GAS bf16x8*)(qp + d0 * 16);
    f32x16 o[4];
#pragma unroll
    for (int c = 0; c < 4; ++c)
#pragma unroll
        for (int r = 0; r < 16; ++r) o[c][r] = 0.f;
    float lsum = 0.f;
    VM_WAIT(); __syncthreads();
    for (int j = 0; j < NT; ++j) {
        const int s = j & 1;
        if (j + 1 < NT) ATT_DMA(j + 1, s ^ 1);
        if (j < ntw) {
            const LAS unsigned char* Kb = lds + s * 32768 + comp * 8192 + hi * 1024 + r32 * 16;
            f32x16 p0, p1;
#pragma unroll
            for (int r = 0; r < 16; ++r) { p0[r] = 0.f; p1[r] = 0.f; }
#pragma unroll
            for (int d0 = 0; d0 < 4; ++d0) {
                const bf16x8 k0 = *(const LAS bf16x8*)(Kb + d0 * 2048), k1 = *(const LAS bf16x8*)(Kb + d0 * 2048 + 512);
                p0 = __builtin_amdgcn_mfma_f32_32x32x16_bf16(k0, qr[d0], p0, 0, 0, 0);
                p1 = __builtin_amdgcn_mfma_f32_32x32x16_bf16(k1, qr[d0], p1, 0, 0, 0);
            }
            float sacc = 0.f;
#pragma unroll
            for (int r = 0; r < 16; ++r) { p0[r] = __builtin_amdgcn_exp2f(p0[r]); p1[r] = __builtin_amdgcn_exp2f(p1[r]); sacc += p0[r] + p1[r]; }
            lsum += sacc;
            v4u pw[4];
            pw[0] = (v4u){pk2(p0[0], p0[1]), pk2(p0[2], p0[3]), pk2(p0[4], p0[5]), pk2(p0[6], p0[7])};
            pw[1] = (v4u){pk2(p0[8], p0[9]), pk2(p0[10], p0[11]), pk2(p0[12], p0[13]), pk2(p0[14], p0[15])};
            pw[2] = (v4u){pk2(p1[0], p1[1]), pk2(p1[2], p1[3]), pk2(p1[4], p1[5]), pk2(p1[6], p1[7])};
            pw[3] = (v4u){pk2(p1[8], p1[9]), pk2(p1[10], p1[11]), pk2(p1[12], p1[13]), pk2(p1[14], p1[15])};
            const LAS unsigned char* Vb = lds + s * 32768 + 16384 + ((lane >> 4) & 1) * 32 + (lane & 3) * 8 + (4 * hi + ((lane & 15) >> 2)) * 64;
#pragma unroll
            for (int cb = 0; cb < 4; ++cb)
#pragma unroll
                for (int ks = 0; ks < 4; ++ks) {
                    const s16x4 lo = vtr(Vb + cb * 4096 + ks * 1024), hh = vtr(Vb + cb * 4096 + ks * 1024 + 512);
                    const bf16x8 vf = {lo[0], lo[1], lo[2], lo[3], hh[0], hh[1], hh[2], hh[3]};
                    o[cb] = __builtin_amdgcn_mfma_f32_32x32x16_bf16(__builtin_bit_cast(bf16x8, pw[ks]), vf, o[cb], 0, 0, 0);
                }
        }
        VM_WAIT(); __syncthreads();
    }
#undef ATT_DMA
    lsum += __shfl_xor(lsum, 32);
    float inv[16];
#pragma unroll
    for (int r = 0; r < 16; ++r) inv[r] = 1.0f / __shfl(lsum, crow(r, hi));
    LAS float* X = (LAS float*)lds;
    if (comp == 1) {
#pragma unroll
        for (int cb = 0; cb < 4; ++cb)
#pragma unroll
            for (int r = 0; r < 16; ++r) X[(32 * rg + crow(r, hi)) * XS + cb * 32 + r32] = lam * o[cb][r] * inv[r];
    }
    __syncthreads();
    if (comp == 0) {
#pragma unroll
        for (int cb = 0; cb < 4; ++cb)
#pragma unroll
            for (int r = 0; r < 16; ++r) { const int idx = (32 * rg + crow(r, hi)) * XS + cb * 32 + r32; X[idx] = o[cb][r] * inv[r] - X[idx]; }
    }
    __syncthreads();
    {
        const int row = 16 * wid + (lane >> 2), c0 = (lane & 3) * 32;
        f32x4 dv[8]; float ss = 0.f;
#pragma unroll
        for (int i = 0; i < 8; ++i) { dv[i] = *(const LAS f32x4*)(X + row * XS + c0 + 4 * i); ss += (dv[i].x * dv[i].x + dv[i].y * dv[i].y) + (dv[i].z * dv[i].z + dv[i].w * dv[i].w); }
        ss += __shfl_xor(ss, 1); ss += __shfl_xor(ss, 2);
        const float rstd = oscale / sqrtf(ss * (1.f / 128.f) + EPS);
        bf16* op = mix + (rowb + t0 + row) * D + h * 128 + c0;
#pragma unroll
        for (int i = 0; i < 4; ++i) { const f32x4 g0 = *(const f32x4*)(subg + c0 + 8 * i), g1 = *(const f32x4*)(subg + c0 + 8 * i + 4); const f32x4 a = dv[2 * i] * g0 * rstd, c = dv[2 * i + 1] * g1 * rstd;
            v4u w; w.x = pk2(a.x, a.y); w.y = pk2(a.z, a.w); w.z = pk2(c.x, c.y); w.w = pk2(c.z, c.w); *(GAS v4u*)(op + 8 * i) = w; }
    }
    __syncthreads();
}
__device__ __forceinline__ void attn_phase(const Args& A, Frame& F, int l) {
    const bf16* u = (const bf16*)(F.ws + WS_U); bf16* mix = (bf16*)(F.ws + WS_MIX);
    const float lam = ((const float*)(F.ws + WS_MISC + MISC_LAM))[l];
    const float lam_init = 0.8f - 0.6f * expf(-0.3f * (float)l);
    const int bh = F.vcu >> 1, pb = (F.vcu & 1) * 4;
    for (int i = 0; i < 4; ++i) {
        const int p = pb + i;
        attn_unit(F, u, mix, bh >> 2, bh & 3, 15 - p, lam, 1.0f - lam_init, A.in[10] + l * 128);
        attn_unit(F, u, mix, bh >> 2, bh & 3, p, lam, 1.0f - lam_init, A.in[10] + l * 128);
    }
}

__device__ __forceinline__ void hgrn_phase(const Args& A, Frame& F, int l) {
    const bf16* u = (const bf16*)(F.ws + WS_U); float* rawo = (float*)(F.ws + WS_RAWO);
    const float* lbl = (const float*)(F.ws + WS_MISC + MISC_LB) + l * 256;
    const int bh = F.vcu >> 1, vhalf = F.vcu & 1, b = bh >> 2, h = bh & 3;
    const int tid = F.tid, lane = F.lane, wid = F.wave;
    LAS unsigned char* lds = F.lds;
    const int tl = tid >> 3, c8 = tid & 7;
    const bf16* zq_p = u + ((size_t)b * SEQ + tl) * DIN + BQ + h * 64 + c8 * 8;
    const bf16* zf_p = u + ((size_t)b * SEQ + tl) * DIN + BF + h * 64 + c8 * 8;
    const bf16* vi_p = u + ((size_t)b * SEQ + tl) * DIN + BI + h * 64 + vhalf * 32 + c8 * 4;
    float lbv[8];
#pragma unroll
    for (int j = 0; j < 8; ++j) lbv[j] = lbl[h * 64 + c8 * 8 + j];
    v4u rq, rf; v2u rv;
#define HG_LOAD(c) do { const size_t go = (size_t)(c) * 64 * DIN; rq = *(const GAS v4u*)(zq_p + go); rf = *(const GAS v4u*)(zf_p + go); rv = *(const GAS v2u*)(vi_p + go); } while (0)
#define HG_STORE(s) do { LAS float* Fs = (LAS float*)(lds + (s) * 40960) + tl * 64 + c8 * 8; LAS float* Qs = Fs + 4096; LAS float* Vs = (LAS float*)(lds + (s) * 40960 + 32768) + tl * 32 + c8 * 4; \
        const unsigned qw[4] = {rq.x, rq.y, rq.z, rq.w}, fw[4] = {rf.x, rf.y, rf.z, rf.w}; float qv[8], fv[8]; \
        _Pragma("unroll") for (int j = 0; j < 4; ++j) { const float z0 = bflo(qw[j]), z1 = bfhi(qw[j]); qv[2 * j] = z0 * fsigmoid(z0); qv[2 * j + 1] = z1 * fsigmoid(z1); \
            const float y0 = bflo(fw[j]), y1 = bfhi(fw[j]); fv[2 * j] = lbv[2 * j] + (1.0f - lbv[2 * j]) * fsigmoid(y0); fv[2 * j + 1] = lbv[2 * j + 1] + (1.0f - lbv[2 * j + 1]) * fsigmoid(y1); } \
        *(LAS f32x4*)(Fs) = (f32x4){fv[0], fv[1], fv[2], fv[3]}; *(LAS f32x4*)(Fs + 4) = (f32x4){fv[4], fv[5], fv[6], fv[7]}; \
        *(LAS f32x4*)(Qs) = (f32x4){qv[0], qv[1], qv[2], qv[3]}; *(LAS f32x4*)(Qs + 4) = (f32x4){qv[4], qv[5], qv[6], qv[7]}; \
        *(LAS f32x4*)(Vs) = (f32x4){bflo(rv.x), bfhi(rv.x), bflo(rv.y), bfhi(rv.y)}; } while (0)
    const int vl = lane >> 4, dg = lane & 15, vv = 4 * wid + vl;
    float S0 = 0.f, S1 = 0.f, S2 = 0.f, S3 = 0.f;
    HG_LOAD(0); HG_STORE(0); __syncthreads();
    for (int c = 0; c < SEQ / 64; ++c) {
        const int s = c & 1;
        if (c + 1 < SEQ / 64) HG_LOAD(c + 1);
        const LAS float* Fs = (const LAS float*)(lds + s * 40960) + 4 * dg; const LAS float* Qs = Fs + 4096; const LAS float* Vs = (const LAS float*)(lds + s * 40960 + 32768) + vv;
        LAS float* OB = (LAS float*)(lds + 81920 + s * 8192);
#pragma unroll 4
        for (int t = 0; t < 64; ++t) {
            const f32x4 f4 = *(const LAS f32x4*)(Fs + t * 64), q4 = *(const LAS f32x4*)(Qs + t * 64); const float v = Vs[t * 32];
            S0 = f4.x * (S0 - v) + v; S1 = f4.y * (S1 - v) + v; S2 = f4.z * (S2 - v) + v; S3 = f4.w * (S3 - v) + v;
            float part = (q4.x * S0 + q4.y * S1) + (q4.z * S2 + q4.w * S3);
            part += __shfl_xor(part, 1); part += __shfl_xor(part, 2); part += __shfl_xor(part, 4); part += __shfl_xor(part, 8);
            if (dg == 0) OB[t * 32 + vv] = part;
        }
        if (c + 1 < SEQ / 64) HG_STORE(s ^ 1);
        __syncthreads();
        *(GAS f32x4*)(rawo + ((size_t)b * SEQ + 64 * c + tl) * 256 + h * 64 + vhalf * 32 + c8 * 4) = *(const LAS f32x4*)(OB + tl * 32 + c8 * 4);
    }
    __syncthreads();
#undef HG_LOAD
#undef HG_STORE
}
__device__ __forceinline__ void hgrn_post_phase(const Args& A, Frame& F, int l) {
    const int gw = F.vcu * 8 + F.wave, NGW = F.G * 8, lane = F.lane;
    const bf16* u = (const bf16*)(F.ws + WS_U); bf16* mix = (bf16*)(F.ws + WS_MIX); const float* rawo = (const float*)(F.ws + WS_RAWO);
    const f32x4 ng = *(const f32x4*)(A.in[12] + l * 64 + (lane & 15) * 4);
    for (int m = gw; m < M; m += NGW) {
        const f32x4 o = *(const GAS f32x4*)(rawo + (size_t)m * 256 + 4 * lane);
        float ss = (o.x * o.x + o.y * o.y) + (o.z * o.z + o.w * o.w);
        ss += __shfl_xor(ss, 1); ss += __shfl_xor(ss, 2); ss += __shfl_xor(ss, 4); ss += __shfl_xor(ss, 8);
        const float rstd = 1.0f / sqrtf(ss * (1.f / 64.f) + EPS);
        const v2u zg = *(const GAS v2u*)(u + (size_t)m * DIN + BG + 4 * lane);
        const float z0 = bflo(zg.x), z1 = bfhi(zg.x), z2 = bflo(zg.y), z3 = bfhi(zg.y);
        v2u w; w.x = pk2(o.x * rstd * ng.x * z0 * fsigmoid(z0), o.y * rstd * ng.y * z1 * fsigmoid(z1)); w.y = pk2(o.z * rstd * ng.z * z2 * fsigmoid(z2), o.w * rstd * ng.w * z3 * fsigmoid(z3));
        *(GAS v2u*)(mix + (size_t)m * D + 512 + 4 * lane) = w;
    }
}

__device__ __forceinline__ void route_phase(const Args& A, Frame& F, int l) {
    const int lane = F.lane, tid = F.tid, wid = F.wave;
    const float* xres = F.out; bf16* XN = (bf16*)(F.ws + WS_XN);
    const float* WrT = (const float*)(F.ws + WS_MISC + MISC_WRT) + (size_t)l * 36 * 1024;
    const float* gffn = A.in[15] + l * D;
    int* tokpos = (int*)(F.ws + WS_MISC + MISC_TOKPOS); float* tokgate = (float*)(F.ws + WS_MISC + MISC_TOKGATE);
    LAS int* lcnt = (LAS int*)(F.lds);
    LAS int* lbase = lcnt + 32;
    LAS int* asg = lcnt + 64;
    if (tid < 32) lcnt[tid] = 0;
    __syncthreads();
    const float biasv = (lane < 32) ? A.in[19][l * 32 + lane] : (lane < 36 ? A.in[17][l * 4 + (lane - 32)] : 0.f);
    const int tb = F.vcu * 256 + wid * 32;
    for (int grp = 0; grp < 8; ++grp) {
        float hv[4][16]; float mylogit[4];
#pragma unroll
        for (int tt = 0; tt < 4; ++tt) {
            const int m = tb + grp * 4 + tt;
            const GAS f32x4* xr = (const GAS f32x4*)(xres + (size_t)m * D) + lane; const GAS f32x4* gr = (const GAS f32x4*)gffn + lane;
            f32x4 v[4]; float s = 0.f;
#pragma unroll
            for (int j = 0; j < 4; ++j) { v[j] = xr[64 * j]; s += (v[j].x * v[j].x + v[j].y * v[j].y) + (v[j].z * v[j].z + v[j].w * v[j].w); }
            const float rstd = 1.0f / sqrtf(wave_sum(s) * (1.f / D) + EPS);
            GAS unsigned long long* o8 = (GAS unsigned long long*)(XN + (size_t)m * D) + lane;
#pragma unroll
            for (int j = 0; j < 4; ++j) { const f32x4 gg = gr[64 * j]; const f32x4 hh = v[j] * rstd * gg;
                hv[tt][4 * j] = hh.x; hv[tt][4 * j + 1] = hh.y; hv[tt][4 * j + 2] = hh.z; hv[tt][4 * j + 3] = hh.w;
                o8[64 * j] = (unsigned long long)pk2(hh.x, hh.y) | ((unsigned long long)pk2(hh.z, hh.w) << 32); }
            mylogit[tt] = 0.f;
        }
#pragma unroll 1
        for (int o = 0; o < 36; ++o) {
            const GAS f32x4* wr_ = (const GAS f32x4*)(WrT + (size_t)o * 1024) + lane;
            f32x4 w[4];
#pragma unroll
            for (int j = 0; j < 4; ++j) w[j] = wr_[64 * j];
#pragma unroll
            for (int tt = 0; tt < 4; ++tt) {
                float a = 0.f;
#pragma unroll
                for (int j = 0; j < 4; ++j) a += (hv[tt][4 * j] * w[j].x + hv[tt][4 * j + 1] * w[j].y) + (hv[tt][4 * j + 2] * w[j].z + hv[tt][4 * j + 3] * w[j].w);
                a = wave_sum(a);
                if (lane == o) mylogit[tt] = a;
            }
        }
#pragma unroll
        for (int tt = 0; tt < 4; ++tt) {
            const int m = tb + grp * 4 + tt; const float lg = mylogit[tt] + biasv;
            float gl[4];
#pragma unroll
            for (int j = 0; j < 4; ++j) gl[j] = __shfl(lg, 32 + j);
            int g = 0; float gm = gl[0];
#pragma unroll
            for (int j = 1; j < 4; ++j) if (gl[j] > gm) { gm = gl[j]; g = j; }
            float den = 0.f;
#pragma unroll
            for (int j = 0; j < 4; ++j) den += expf(gl[j] - gm);
            const float pg = 1.0f / den;
            float ev[8];
#pragma unroll
            for (int j = 0; j < 8; ++j) ev[j] = __shfl(lg, 8 * g + j);
            int i1 = 0; float v1 = ev[0];
#pragma unroll
            for (int j = 1; j < 8; ++j) if (ev[j] > v1) { v1 = ev[j]; i1 = j; }
            int i2 = -1; float v2 = -3.0e38f;
#pragma unroll
            for (int j = 0; j < 8; ++j) if (j != i1 && ev[j] > v2) { v2 = ev[j]; i2 = j; }
            const float e21 = expf(v2 - v1), w1 = 1.0f / (1.0f + e21), w2 = e21 * w1;
            if (lane == 0) {
                const int e1 = 8 * g + i1, e2 = 8 * g + i2;
                const int lp1 = atomicAdd((int*)&lcnt[e1], 1), lp2 = atomicAdd((int*)&lcnt[e2], 1);
                const int tl_ = wid * 32 + grp * 4 + tt;
                asg[tl_ * 2] = (e1 << 16) | lp1; asg[tl_ * 2 + 1] = (e2 << 16) | lp2;
                tokgate[(size_t)m * 2] = pg * w1; tokgate[(size_t)m * 2 + 1] = pg * w2;
            }
        }
    }
    __syncthreads();
    if (tid < 32) lbase[tid] = (int)__hip_atomic_fetch_add((unsigned*)(F.ctl + CW_CNT + l * 32 + tid), (unsigned)lcnt[tid], RLX_AGENT);
    __syncthreads();
    { const int a = asg[tid]; const int e = a >> 16, lp = a & 0xffff; tokpos[(size_t)(F.vcu * 256) * 2 + tid] = (e << 16) | (lbase[e] + lp); }
    __syncthreads();
}
__device__ __forceinline__ void moe_tables(Frame& F, int l) {
    LAS int* ts = (LAS int*)(F.lds + TAB_OFF); LAS int* ut = (LAS int*)(F.lds + TAB_OFF + 256);
    __syncthreads();
    if (F.tid == 0) { int acc = 0;
        for (int e = 0; e < 32; ++e) { ts[e] = acc; acc += ((int)__hip_atomic_load((unsigned*)(F.ctl + CW_CNT + l * 32 + e), RLX_AGENT) + 255) >> 8; }
        ts[32] = acc; }
    __syncthreads();
    if (F.tid < 16) { const int L = F.tid * F.G + F.vcu; int p = -1;
        if (L < 4 * ts[32]) { const int rt = L >> 2; int e = 0; for (int j = 1; j < 32; ++j) e += (ts[j] <= rt) ? 1 : 0; p = (e << 24) | L; }
        ut[F.tid] = p; }
    __syncthreads();
}
__device__ __forceinline__ void gather_phase(Frame& F, int l) {
    moe_tables(F, l);
    const LAS int* ts = (const LAS int*)(F.lds + TAB_OFF);
    const int gw = F.vcu * 8 + F.wave, NGW = F.G * 8, lane = F.lane;
    const bf16* XN = (const bf16*)(F.ws + WS_XN); bf16* Xg = (bf16*)(F.ws + WS_XG);
    const int* tokpos = (const int*)(F.ws + WS_MISC + MISC_TOKPOS); int* tokslot = (int*)(F.ws + WS_MISC + MISC_TOKSLOT);
    for (int m = gw; m < M; m += NGW) {
        const v4u a = *(const GAS v4u*)(XN + (size_t)m * D + 8 * lane), b = *(const GAS v4u*)(XN + (size_t)m * D + 512 + 8 * lane);
#pragma unroll
        for (int k = 0; k < 2; ++k) { const int tp = tokpos[(size_t)m * 2 + k]; const int e = tp >> 16, pos = tp & 0xffff; const int slot = ts[e] * 256 + pos;
            *(GAS v4u*)(Xg + (size_t)slot * D + 8 * lane) = a; *(GAS v4u*)(Xg + (size_t)slot * D + 512 + 8 * lane) = b;
            if (lane == 0) tokslot[(size_t)m * 2 + k] = slot; }
    }
}
__device__ __forceinline__ void combine_phase(const Args& A, Frame& F, int l) {
    const int gw = F.vcu * 8 + F.wave, NGW = F.G * 8, lane = F.lane;
    float* xres = F.out; const bf16* Y = (const bf16*)(F.ws + WS_XG); bf16* XN = (bf16*)(F.ws + WS_XN);
    const int* tokslot = (const int*)(F.ws + WS_MISC + MISC_TOKSLOT); const float* tokgate = (const float*)(F.ws + WS_MISC + MISC_TOKGATE);
    const bool donorm = (l + 1 < DEPTH); const float* gn = A.in[2] + (l + 1 < DEPTH ? (l + 1) * D : 0);
    for (int m = gw; m < M; m += NGW) {
        const int s0 = tokslot[(size_t)m * 2], s1 = tokslot[(size_t)m * 2 + 1]; const float g0 = tokgate[(size_t)m * 2], g1 = tokgate[(size_t)m * 2 + 1];
        GAS f32x4* xr = (GAS f32x4*)(xres + (size_t)m * D) + lane;
        const GAS v2u* y0 = (const GAS v2u*)(Y + (size_t)s0 * D) + lane; const GAS v2u* y1 = (const GAS v2u*)(Y + (size_t)s1 * D) + lane;
        f32x4 v[4]; float s = 0.f;
#pragma unroll
        for (int j = 0; j < 4; ++j) { v[j] = xr[64 * j]; const v2u a = y0[64 * j], b = y1[64 * j];
            v[j].x += g0 * bflo(a.x) + g1 * bflo(b.x); v[j].y += g0 * bfhi(a.x) + g1 * bfhi(b.x); v[j].z += g0 * bflo(a.y) + g1 * bflo(b.y); v[j].w += g0 * bfhi(a.y) + g1 * bfhi(b.y);
            xr[64 * j] = v[j]; s += (v[j].x * v[j].x + v[j].y * v[j].y) + (v[j].z * v[j].z + v[j].w * v[j].w); }
        if (donorm) {
            const float rstd = 1.0f / sqrtf(wave_sum(s) * (1.f / D) + EPS);
            const GAS f32x4* gr = (const GAS f32x4*)gn + lane; GAS unsigned long long* o8 = (GAS unsigned long long*)(XN + (size_t)m * D) + lane;
#pragma unroll
            for (int j = 0; j < 4; ++j) { const f32x4 gg = gr[64 * j]; o8[64 * j] = (unsigned long long)pk2(v[j].x * rstd * gg.x, v[j].y * rstd * gg.y) | ((unsigned long long)pk2(v[j].z * rstd * gg.z, v[j].w * rstd * gg.w) << 32); }
        }
    }
}

constexpr int PH_PER_LAYER = 10, N_PHASES = 1 + DEPTH * PH_PER_LAYER;
__global__ void __launch_bounds__(512, 2) mk_fwd(Args args) {
    extern __shared__ __attribute__((aligned(16))) unsigned char lds[];
    Frame F;
    F.lds = (LAS unsigned char*)lds;
    F.MISC = (volatile LAS unsigned*)(F.lds + MISC_OFF);
    F.tid = threadIdx.x; F.lane = F.tid & 63; F.wave = __builtin_amdgcn_readfirstlane(F.tid >> 6);
    F.G = gridDim.x; { const int bx = blockIdx.x; F.vcu = (F.G % 8 == 0) ? (bx % 8) * (F.G / 8) + bx / 8 : bx; }
    F.ws = args.ws; F.out = args.out; F.ctl = (gu32*)(args.ws + WS_CTL);
    for (int u = F.tid; u < (LDS_BYTES - LDSCTL_OFF) / 4; u += 512) ((LAS unsigned*)(F.lds + LDSCTL_OFF))[u] = 0u;
    __syncthreads();
    const int lo = args.ph_lo, hi = args.ph_hi;
    const bool multi = (hi - lo) > 1;
    XcdBarrier bar; bar.bar = (unsigned*)(F.ctl + CW_BAR); bar.x = 0; bar.st = nullptr;
    if (multi) bar = xcd_barrier_post((unsigned*)(F.ctl + CW_BAR), F.MISC + 8);
#ifndef PHSEL
#define PHSEL(j) true
#endif
#define IN(k) (lo <= (k) && (k) < hi)
#define ENTER() do { int t_ = threadIdx.x; asm volatile("" : "+v"(t_)); F.tid = t_; F.lane = t_ & 63; F.wave = __builtin_amdgcn_readfirstlane(t_ >> 6); } while (0)
#define SEAM(k) do { if (IN(k) && IN((k) + 1)) xcd_barrier(bar); } while (0)
    unsigned char* ws = args.ws;
    if (PHSEL(100) && IN(0)) { ENTER(); p0_prologue(args, F); SEAM(0); }
    for (int l = 0; l < DEPTH; ++l) {
        const int pb = 1 + l * PH_PER_LAYER;
        if (PHSEL(0) && IN(pb + 0)) {
            ENTER();
            pg8::DenseOrder S; S.init(ws + WS_XN, ws + WS_WIN + (size_t)l * DIN * D * 2, M, DIN, D, F.G, (int)blockIdx.x);
            pg8::EpiStoreBf16 E{(bf16*)(ws + WS_U), DIN};
            pg8::gemm_phase<pg8::EpiStoreBf16, pg8::DenseOrder>(F.lds + RING_OFF, D, S, E, F.tid);
            SEAM(pb + 0);
        }
        if (PHSEL(1) && IN(pb + 1)) { ENTER(); prep_phase(args, F, l); SEAM(pb + 1); }
        if (PHSEL(2) && IN(pb + 2)) { ENTER(); hgrn_phase(args, F, l); ENTER(); attn_phase(args, F, l); SEAM(pb + 2); }
        if (PHSEL(3) && IN(pb + 3)) { ENTER(); hgrn_post_phase(args, F, l); SEAM(pb + 3); }
        if (PHSEL(4) && IN(pb + 4)) {
            ENTER();
            pg8::DenseOrder S; S.init(ws + WS_MIX, ws + WS_WOUT + (size_t)l * D * D * 2, M, D, D, F.G, (int)blockIdx.x);
            pg8::EpiResF32 E{l == 0 ? args.in[0] : (const float*)F.out, F.out};
            pg8::gemm_phase<pg8::EpiResF32, pg8::DenseOrder>(F.lds + RING_OFF, D, S, E, F.tid);
            SEAM(pb + 4);
        }
        if (PHSEL(5) && IN(pb + 5)) { ENTER(); route_phase(args, F, l); SEAM(pb + 5); }
        if (PHSEL(6) && IN(pb + 6)) { ENTER(); gather_phase(F, l); SEAM(pb + 6); }
        if (PHSEL(7) && IN(pb + 7)) {
            ENTER();
            moe_tables(F, l);
            pg8::MoeOrder S{(const char*)(ws + WS_XG), (const char*)(ws + WS_WGU + (size_t)l * 32 * D * D * 2), D, (size_t)D * D * 2, (unsigned)(uintptr_t)(F.lds + TAB_OFF + 256), 128};
            pg8::EpiSwiGLU E{(bf16*)(ws + WS_ACT)};
            pg8::gemm_phase<pg8::EpiSwiGLU, pg8::MoeOrder>(F.lds + RING_OFF, D, S, E, F.tid);
            SEAM(pb + 7);
        }
        if (PHSEL(8) && IN(pb + 8)) {
            ENTER();
            moe_tables(F, l);
            pg8::MoeOrder S{(const char*)(ws + WS_ACT), (const char*)(ws + WS_WD + (size_t)l * 32 * D * DEXP * 2), DEXP, (size_t)D * DEXP * 2, (unsigned)(uintptr_t)(F.lds + TAB_OFF + 256), 256};
            pg8::EpiStoreBf16 E{(bf16*)(ws + WS_XG), D};
            pg8::gemm_phase<pg8::EpiStoreBf16, pg8::MoeOrder>(F.lds + RING_OFF, DEXP, S, E, F.tid);
            SEAM(pb + 8);
        }
        if (PHSEL(9) && IN(pb + 9)) { ENTER(); combine_phase(args, F, l); SEAM(pb + 9); }
    }
#undef IN
#undef SEAM
}

extern "C" void kernel_launch(void* const* d_in, const int* in_sizes, int n_in, void* d_out, int out_size, void* d_ws, size_t ws_size, hipStream_t stream) {
    static int grid = 0;
    if (grid == 0) {
        if (n_in != 23 || in_sizes[0] != M * D || out_size != M * D || ws_size < WS_END) { fprintf(stderr, "kernel_launch: unexpected shapes (n_in %d, in0 %d, out %d, ws %zu < %zu); nothing launched\n", n_in, n_in > 0 ? in_sizes[0] : -1, out_size, ws_size, (size_t)WS_END); grid = -1; return; }
        int dev = 0, cus = 0, per_cu = 0;
        if (hipGetDevice(&dev) != hipSuccess || hipDeviceGetAttribute(&cus, hipDeviceAttributeMultiprocessorCount, dev) != hipSuccess) { grid = -1; return; }
        if (hipFuncSetAttribute((const void*)mk_fwd, hipFuncAttributeMaxDynamicSharedMemorySize, LDS_BYTES) != hipSuccess) { fprintf(stderr, "kernel_launch: hipFuncSetAttribute failed\n"); grid = -1; return; }
        if (hipOccupancyMaxActiveBlocksPerMultiprocessor(&per_cu, (const void*)mk_fwd, 512, LDS_BYTES) != hipSuccess || per_cu < 1) { fprintf(stderr, "kernel_launch: occupancy query reports %d\n", per_cu); }
        (void)hipGetLastError();
        grid = cus;
        if (grid != 256) { fprintf(stderr, "kernel_launch: built for 256 CUs, device has %d\n", grid); grid = -1; return; }
    }
    if (grid < 0) return;
    if (hipMemsetAsync((char*)d_ws + WS_CTL, 0, CTL_ZERO_BYTES, stream) != hipSuccess) return;
    Args a{};
    for (int i = 0; i < 23; ++i) a.in[i] = (const float*)d_in[i];
    a.out = (float*)d_out; a.ws = (unsigned char*)d_ws;
    if (MK_N_LAUNCHES == 1) {
        a.ph_lo = 0; a.ph_hi = N_PHASES;
        hipLaunchKernelGGL(mk_fwd, dim3(grid), dim3(512), LDS_BYTES, stream, a);
    } else {
        for (int p = 0; p < N_PHASES; ++p) { a.ph_lo = p; a.ph_hi = p + 1; hipLaunchKernelGGL(mk_fwd, dim3(grid), dim3(512), LDS_BYTES, stream, a); }
    }
}
```

```cpp
#include <hip/hip_runtime.h>
#include <hip/hip_bf16.h>
#include <cstdio>
#include <cstdint>

#define LAS __attribute__((address_space(3)))
#define GAS __attribute__((address_space(1)))

#ifndef MK_N_LAUNCHES
#define MK_N_LAUNCHES 1
#endif

#ifndef PROBE_MASK_A
#define PROBE_MASK_A 0u
#endif
#ifndef PROBE_MASK_B
#define PROBE_MASK_B 0u
#endif
#ifndef PROBE_SCALE
#define PROBE_SCALE 0.02f
#endif
#define PROBE ((PROBE_MASK_A) != 0u || (PROBE_MASK_B) != 0u)
constexpr int D = 1024, BATCH = 32, SEQ = 2048, M = BATCH * SEQ, DEPTH = 2;
constexpr int DIN = 3328, NEXP = 32, DEXP = 512;
constexpr int CAP = 2 * M + NEXP * 256;
constexpr int AQ = 0, AK = 512, AV = 1024, BQ = 1536, BF = 1792, BI = 2048, BG = 2304, CB = 2560, CC = 2816, CX = 3072;
constexpr float EPS = 1e-6f;
constexpr float QSCALE = 0.125f * 1.4426950408889634f;

namespace pg8 {
typedef unsigned short bf16_t;
typedef short bf16x8 __attribute__((ext_vector_type(8)));
typedef float f32x4 __attribute__((ext_vector_type(4)));
typedef unsigned u32x4 __attribute__((ext_vector_type(4)));
constexpr int BM = 256, BK = 64, HALF = 128, HTB = HALF * BK * 2, STAGE_BYTES = 8 * HTB, NXCD = 8, WGM = 8;

__host__ __device__ __forceinline__ int lds_byte(int r, int c) { const int st = (r >> 4) * 2 + (c >> 5), rr = r & 15, cc = c & 31, ob = rr * 64 + cc * 2; return st * 1024 + (ob ^ (((ob >> 9) & 1) << 5)); }
__host__ __device__ __forceinline__ void stage_rc(int b, int& R, int& C) { const int st = b / 1024, sb = b % 1024, swz = sb ^ (((sb >> 9) & 1) << 5); R = (st >> 1) * 16 + swz / 64; C = (st & 1) * 32 + (swz % 64) / 2; }
__host__ __device__ __forceinline__ void stage_rc8(int b, int& R, int& C) { const int st = b / 1024, sb = b % 1024, swz = sb ^ (((sb >> 9) & 1) << 5); R = (st >> 1) * 16 + swz / 64; C = (2 * ((swz % 64) / 16) + (st & 1)) * 8; }
__host__ __device__ __forceinline__ int perm32(int rho) { const int n = rho >> 4, i = rho & 15; return 8 * (i >> 2) + 4 * n + (i & 3); }

struct Unit { const char* A; const char* B; int row0; int col0; const int* toks; const float* aux; int nvalid; };

struct DenseOrder {
    static constexpr bool GATHER = false;
    const char* A; const char* Bt; int K; int nM, nN, nwg, G, c;
    __device__ void init(const void* A_, const void* Bt_, int M_, int N_, int K_, int G_, int c_) { A = (const char*)A_; Bt = (const char*)Bt_; K = K_; nM = M_ / BM; nN = N_ / BM; nwg = nM * nN; G = G_; c = c_; }
    __device__ bool next(int i, Unit& u) const {
        const long L = (long)i * G + c; if (L >= nwg) return false;
        int wgid = (int)L; { const int q = nwg / NXCD, r = nwg % NXCD, xcd = wgid % NXCD, off = wgid / NXCD; wgid = (xcd < r ? xcd * (q + 1) : r * (q + 1) + (xcd - r) * q) + off; }
        const int nig = WGM * nN, gid = wgid / nig, fm = gid * WGM, gsz = (nM - fm) < WGM ? (nM - fm) : WGM;
        const int pm = fm + ((wgid % nig) % gsz), pn = (wgid % nig) / gsz;
        u.A = A + (size_t)pm * BM * K * 2; u.B = Bt + (size_t)pn * BM * K * 2; u.row0 = pm * BM; u.col0 = pn * BM; u.toks = nullptr; u.aux = nullptr; u.nvalid = BM; return true;
    }
};
__device__ __forceinline__ int lds_ld_asm(unsigned addr) { int v; asm volatile("ds_read_b32 %0, %1\n\ts_waitcnt lgkmcnt(0)" : "=&v"(v) : "v"(addr) : "memory"); return v; }
template <bool GATHER_> struct MoeOrder {
    static constexpr bool GATHER = GATHER_;
    const char* A; const char* W; int K; size_t wstride; unsigned tab; int colw;
    const int* list; const float* lrs;
    __device__ bool next(int i, Unit& u) const {
        if (i >= 16) return false;
        const int p = __builtin_amdgcn_readfirstlane(lds_ld_asm(tab + 12u * (unsigned)i));
        if (p < 0) return false;
        const int e = p >> 24, L = p & 0xffffff, rt = L >> 2, pn = L & 3;
        u.B = W + (size_t)e * wstride + (size_t)pn * BM * K * 2; u.row0 = rt * BM; u.col0 = pn * colw; u.toks = nullptr; u.aux = nullptr; u.nvalid = BM;
        if constexpr (GATHER) {
            const int rel = __builtin_amdgcn_readfirstlane(lds_ld_asm(tab + 12u * (unsigned)i + 4u)), nv = __builtin_amdgcn_readfirstlane(lds_ld_asm(tab + 12u * (unsigned)i + 8u));
            u.A = A; u.toks = list + (size_t)e * 65536 + (size_t)rel * BM; u.aux = lrs + (size_t)e * 65536 + (size_t)rel * BM; u.nvalid = nv;
        } else u.A = A + (size_t)rt * BM * K * 2;
        return true;
    }
};

__device__ __forceinline__ unsigned cvt_pk_bf16(float lo, float hi) { unsigned r; asm volatile("v_cvt_pk_bf16_f32 %0, %1, %2" : "=v"(r) : "v"(lo), "v"(hi)); return r; }

struct EpiStoreBf16 {
    static constexpr bool PERM = true; static constexpr bool PERM16 = false; static constexpr int NST = 16;
    bf16_t* O; int ldc; const float* rs;
    __device__ __forceinline__ void operator()(const f32x4 (&acc)[2][2][4][2], const Unit& u, int wr, int wc, int fr, int fq) const {
        const int row0 = u.row0 + wr * 64 + fr, col0 = u.col0 + wc * 32 + 8 * fq;
#pragma unroll
        for (int ai = 0; ai < 2; ++ai)
#pragma unroll
            for (int m = 0; m < 4; ++m) { bf16_t* rowp = O + (size_t)(row0 + ai * HALF + m * 16) * ldc + col0; const float rr = rs ? rs[row0 + ai * HALF + m * 16] : 1.0f;
#pragma unroll
                for (int bj = 0; bj < 2; ++bj) { const f32x4 v0 = acc[ai][bj][m][0] * rr, v1 = acc[ai][bj][m][1] * rr;
                    u32x4 w; w.x = cvt_pk_bf16(v0[0], v0[1]); w.y = cvt_pk_bf16(v0[2], v0[3]); w.z = cvt_pk_bf16(v1[0], v1[1]); w.w = cvt_pk_bf16(v1[2], v1[3]);
                    *(u32x4*)(rowp + bj * HALF) = w; } }
    }
};
struct EpiStoreFp8 {
    static constexpr bool PERM = true; static constexpr bool PERM16 = true; static constexpr int NST = 8;
    unsigned char* O; float k8;
    __device__ __forceinline__ void operator()(const f32x4 (&acc)[2][2][4][2], const Unit& u, int wr, int wc, int fr, int fq) const {
        const int row0 = u.row0 + wr * 64 + fr, col0 = u.col0 + wc * 64 + 16 * fq;
#pragma unroll
        for (int ai = 0; ai < 2; ++ai)
#pragma unroll
            for (int m = 0; m < 4; ++m) { unsigned char* rowp = O + (size_t)(row0 + ai * HALF + m * 16) * 1024 + col0;
                unsigned w[4];
#pragma unroll
                for (int bj = 0; bj < 2; ++bj)
#pragma unroll
                    for (int n = 0; n < 2; ++n) { const f32x4 v = acc[ai][bj][m][n]; int t = 0;
                        t = __builtin_amdgcn_cvt_pk_fp8_f32(__builtin_amdgcn_fmed3f(k8 * v[0], -440.f, 440.f), __builtin_amdgcn_fmed3f(k8 * v[1], -440.f, 440.f), t, false);
                        t = __builtin_amdgcn_cvt_pk_fp8_f32(__builtin_amdgcn_fmed3f(k8 * v[2], -440.f, 440.f), __builtin_amdgcn_fmed3f(k8 * v[3], -440.f, 440.f), t, true); w[bj * 2 + n] = (unsigned)t; }
                *(u32x4*)rowp = (u32x4){w[0], w[1], w[2], w[3]}; }
    }
};
template <bool PN> struct EpiInProjT {
    static constexpr bool PERM = true; static constexpr bool PERM16 = false; static constexpr int NST = 16;
    bf16_t* O; const float* rs; const float* gq; const float* gk; const float* rope; LAS float* T; float asc;
    __device__ __forceinline__ void operator()(const f32x4 (&acc)[2][2][4][2], const Unit& u, int wr, int wc, int fr, int fq) const {
        const int row0 = u.row0 + wr * 64 + fr, col0 = u.col0 + wc * 32 + 8 * fq;
        if (u.col0 >= 1024) {
#pragma unroll
            for (int ai = 0; ai < 2; ++ai)
#pragma unroll
                for (int m = 0; m < 4; ++m) { bf16_t* rowp = O + (size_t)(row0 + ai * HALF + m * 16) * DIN + col0; const float rr = PN ? asc : rs[row0 + ai * HALF + m * 16] * asc;
#pragma unroll
                    for (int bj = 0; bj < 2; ++bj) { const f32x4 v0 = acc[ai][bj][m][0] * rr, v1 = acc[ai][bj][m][1] * rr;
                        u32x4 w; w.x = cvt_pk_bf16(v0[0], v0[1]); w.y = cvt_pk_bf16(v0[2], v0[3]); w.z = cvt_pk_bf16(v1[0], v1[1]); w.w = cvt_pk_bf16(v1[2], v1[3]);
                        *(u32x4*)(rowp + bj * HALF) = w; } }
            return;
        }
        const int wid = wr * 4 + wc;
        LAS float* Tw = T + wid * 256 + fr; LAS float* Tx = T + (wid ^ 1) * 256 + fr;
        asm volatile("" : "+v"(Tw), "+v"(Tx));
        float rrv[2][4], ssl[2][4][2];
#pragma unroll
        for (int ai = 0; ai < 2; ++ai)
#pragma unroll
            for (int m = 0; m < 4; ++m) { const float rr = PN ? asc : rs[row0 + ai * HALF + m * 16] * asc; rrv[ai][m] = rr;
#pragma unroll
                for (int bj = 0; bj < 2; ++bj) { const f32x4 v0 = acc[ai][bj][m][0], v1 = acc[ai][bj][m][1];
                    float ss = ((v0[0] * v0[0] + v0[1] * v0[1]) + (v0[2] * v0[2] + v0[3] * v0[3])) + ((v1[0] * v1[0] + v1[1] * v1[1]) + (v1[2] * v1[2] + v1[3] * v1[3]));
                    ss += __shfl_xor(ss, 16); ss += __shfl_xor(ss, 32); ss *= rr * rr; ssl[ai][m][bj] = ss;
                    if (fq == 0) Tw[((ai * 4 + m) * 2 + bj) * 16] = ss; } }
        asm volatile("s_waitcnt lgkmcnt(0)" ::: "memory"); __builtin_amdgcn_s_barrier(); asm volatile("" ::: "memory");
        const bool isq = u.col0 < 512;
        const float* gsrc = (isq ? gq : gk) + (wc & 1) * 32 + 8 * fq;
        float gn[8];
#pragma unroll
        for (int j = 0; j < 8; ++j) gn[j] = gsrc[j] * (isq ? QSCALE : 1.0f);
        const bool rot = ((wc & 1) == 0) && (fq < 2);
#pragma unroll
        for (int ai = 0; ai < 2; ++ai)
#pragma unroll
            for (int m = 0; m < 4; ++m) { const int row = row0 + ai * HALF + m * 16; bf16_t* rowp = O + (size_t)row * DIN + col0;
                const f32x4 c0 = *(const f32x4*)(rope + (size_t)row * 16), c1 = *(const f32x4*)(rope + (size_t)row * 16 + 4), s0 = *(const f32x4*)(rope + (size_t)row * 16 + 8), s1 = *(const f32x4*)(rope + (size_t)row * 16 + 12);
                const float cs[8] = {c0[0], c0[1], c0[2], c0[3], c1[0], c1[1], c1[2], c1[3]}, sn[8] = {s0[0], s0[1], s0[2], s0[3], s1[0], s1[1], s1[2], s1[3]};
#pragma unroll
                for (int bj = 0; bj < 2; ++bj) {
                    const float tot = ssl[ai][m][bj] + Tx[((ai * 4 + m) * 2 + bj) * 16];
                    const float sc = rrv[ai][m] / sqrtf(tot * (1.f / 64.f) + EPS);
                    const f32x4 v0 = acc[ai][bj][m][0], v1 = acc[ai][bj][m][1];
                    float v[8] = {v0[0] * sc * gn[0], v0[1] * sc * gn[1], v0[2] * sc * gn[2], v0[3] * sc * gn[3], v1[0] * sc * gn[4], v1[1] * sc * gn[5], v1[2] * sc * gn[6], v1[3] * sc * gn[7]};
#pragma unroll
                    for (int j = 0; j < 8; ++j) { const float p = __shfl_xor(v[j], 16);
                        const float r0 = v[j] * cs[j] - p * sn[j], r1 = p * sn[j] + v[j] * cs[j];
                        v[j] = rot ? (fq == 0 ? r0 : r1) : v[j]; }
                    u32x4 w; w.x = cvt_pk_bf16(v[0], v[1]); w.y = cvt_pk_bf16(v[2], v[3]); w.z = cvt_pk_bf16(v[4], v[5]); w.w = cvt_pk_bf16(v[6], v[7]);
                    *(u32x4*)(rowp + bj * HALF) = w; } }
        asm volatile("s_waitcnt lgkmcnt(0)" ::: "memory");
    }
};
typedef EpiInProjT<false> EpiInProj;
template <bool PN> struct EpiInProj16T {
    static constexpr bool AUXPRE = false; static constexpr bool PERM = true; static constexpr bool PERM16 = true; static constexpr int NST = 16;
    bf16_t* O; const float* rs; const float* gq; const float* gk; const float* rope; float asc;
    __device__ __forceinline__ void operator()(const f32x4 (&acc)[2][2][4][2], const Unit& u, int wr, int wc, int fr, int fq) const {
        const int row0 = u.row0 + wr * 64 + fr, col0 = u.col0 + wc * 64 + 16 * fq;
        if (u.col0 >= 1024) {
#pragma unroll
            for (int ai = 0; ai < 2; ++ai)
#pragma unroll
                for (int m = 0; m < 4; ++m) { bf16_t* rowp = O + (size_t)(row0 + ai * HALF + m * 16) * DIN + col0; const float rr = PN ? asc : rs[row0 + ai * HALF + m * 16] * asc;
                    u32x4 w[2];
#pragma unroll
                    for (int bj = 0; bj < 2; ++bj) { const f32x4 v0 = acc[ai][bj][m][0] * rr, v1 = acc[ai][bj][m][1] * rr;
                        w[bj].x = cvt_pk_bf16(v0[0], v0[1]); w[bj].y = cvt_pk_bf16(v0[2], v0[3]); w[bj].z = cvt_pk_bf16(v1[0], v1[1]); w[bj].w = cvt_pk_bf16(v1[2], v1[3]); }
                    *(u32x4*)rowp = w[0]; *(u32x4*)(rowp + 8) = w[1]; }
            return;
        }
        const bool isq = u.col0 < 512;
        const float* gsrc = (isq ? gq : gk) + 16 * fq;
        float gn[16];
#pragma unroll
        for (int j = 0; j < 16; ++j) gn[j] = gsrc[j] * (isq ? QSCALE : 1.0f);
#pragma unroll
        for (int ai = 0; ai < 2; ++ai)
#pragma unroll
            for (int m = 0; m < 4; ++m) { const int row = row0 + ai * HALF + m * 16; bf16_t* rowp = O + (size_t)row * DIN + col0; const float rr = PN ? asc : rs[row] * asc;
                const f32x4 c0 = *(const f32x4*)(rope + (size_t)row * 16), c1 = *(const f32x4*)(rope + (size_t)row * 16 + 4), s0 = *(const f32x4*)(rope + (size_t)row * 16 + 8), s1 = *(const f32x4*)(rope + (size_t)row * 16 + 12);
                const float cs[8] = {c0[0], c0[1], c0[2], c0[3], c1[0], c1[1], c1[2], c1[3]}, sn[8] = {s0[0], s0[1], s0[2], s0[3], s1[0], s1[1], s1[2], s1[3]};
                float v[16];
#pragma unroll
                for (int bj = 0; bj < 2; ++bj)
#pragma unroll
                    for (int n = 0; n < 2; ++n)
#pragma unroll
                        for (int i = 0; i < 4; ++i) v[8 * bj + 4 * n + i] = acc[ai][bj][m][n][i];
                float ss = 0.f;
#pragma unroll
                for (int j = 0; j < 16; ++j) ss += v[j] * v[j];
                ss += __shfl_xor(ss, 16); ss += __shfl_xor(ss, 32); ss *= rr * rr;
                const float sc = rr / sqrtf(ss * (1.f / 64.f) + EPS);
#pragma unroll
                for (int j = 0; j < 16; ++j) v[j] *= sc * gn[j];
                if (fq == 0) {
#pragma unroll
                    for (int d = 0; d < 8; ++d) { const float x1 = v[d], x2 = v[d + 8]; v[d] = x1 * cs[d] - x2 * sn[d]; v[d + 8] = x1 * sn[d] + x2 * cs[d]; }
                }
                u32x4 w0, w1;
                w0.x = cvt_pk_bf16(v[0], v[1]); w0.y = cvt_pk_bf16(v[2], v[3]); w0.z = cvt_pk_bf16(v[4], v[5]); w0.w = cvt_pk_bf16(v[6], v[7]);
                w1.x = cvt_pk_bf16(v[8], v[9]); w1.y = cvt_pk_bf16(v[10], v[11]); w1.z = cvt_pk_bf16(v[12], v[13]); w1.w = cvt_pk_bf16(v[14], v[15]);
                *(u32x4*)rowp = w0; *(u32x4*)(rowp + 8) = w1; }
    }
};
struct EpiSwiGLU {
    static constexpr bool PERM = true; static constexpr bool PERM16 = false;
    bf16_t* O;
    __device__ __forceinline__ void operator()(const f32x4 (&acc)[2][2][4][2], const Unit& u, int wr, int wc, int fr, int fq) const {
        const int row0 = u.row0 + wr * 64 + fr, col0 = u.col0 + wc * 32 + 8 * fq;
#pragma unroll
        for (int ai = 0; ai < 2; ++ai)
#pragma unroll
            for (int m = 0; m < 4; ++m) { bf16_t* rowp = O + (size_t)(row0 + ai * HALF + m * 16) * DEXP + col0; const float rr = u.aux[wr * 64 + fr + ai * HALF + m * 16];
                float a[8];
#pragma unroll
                for (int n = 0; n < 2; ++n)
#pragma unroll
                    for (int j = 0; j < 4; ++j) { const float g = acc[ai][0][m][n][j] * rr, up = acc[ai][1][m][n][j] * rr;
                        a[n * 4 + j] = g * __builtin_amdgcn_rcpf(1.0f + __builtin_amdgcn_exp2f(-1.4426950408889634f * g)) * up; }
                u32x4 w; w.x = cvt_pk_bf16(a[0], a[1]); w.y = cvt_pk_bf16(a[2], a[3]); w.z = cvt_pk_bf16(a[4], a[5]); w.w = cvt_pk_bf16(a[6], a[7]);
                *(u32x4*)rowp = w; }
    }
};
struct EpiSwiGLU8 {
    static constexpr bool PERM = true; static constexpr bool PERM16 = false; static constexpr int NST = 8;
    unsigned char* O; float asc;
    __device__ __forceinline__ void operator()(const f32x4 (&acc)[2][2][4][2], const Unit& u, int wr, int wc, int fr, int fq) const {
        const int row0 = u.row0 + wr * 64 + fr, col0 = u.col0 + wc * 32 + 8 * fq;
#pragma unroll
        for (int ai = 0; ai < 2; ++ai)
#pragma unroll
            for (int m = 0; m < 4; ++m) { unsigned char* rowp = O + (size_t)(row0 + ai * HALF + m * 16) * DEXP + col0; const float rr = u.aux[wr * 64 + fr + ai * HALF + m * 16] * asc;
                float a[8];
#pragma unroll
                for (int n = 0; n < 2; ++n)
#pragma unroll
                    for (int j = 0; j < 4; ++j) { const float g = acc[ai][0][m][n][j] * rr, up = acc[ai][1][m][n][j] * rr;
                        a[n * 4 + j] = __builtin_amdgcn_fmed3f(8.0f * g * __builtin_amdgcn_rcpf(1.0f + __builtin_amdgcn_exp2f(-1.4426950408889634f * g)) * up, -440.0f, 440.0f); }
                int w0 = 0, w1 = 0;
                w0 = __builtin_amdgcn_cvt_pk_fp8_f32(a[0], a[1], w0, false); w0 = __builtin_amdgcn_cvt_pk_fp8_f32(a[2], a[3], w0, true);
                w1 = __builtin_amdgcn_cvt_pk_fp8_f32(a[4], a[5], w1, false); w1 = __builtin_amdgcn_cvt_pk_fp8_f32(a[6], a[7], w1, true);
                typedef unsigned u32x2 __attribute__((ext_vector_type(2)));
                *(u32x2*)rowp = (u32x2){(unsigned)w0, (unsigned)w1}; }
    }
};
struct EpiResBf16 {
    static constexpr bool PERM = true; static constexpr bool PERM16 = false; static constexpr int NST = 16;
    bf16_t* X; float asc;
    __device__ __forceinline__ void operator()(const f32x4 (&acc)[2][2][4][2], const Unit& u, int wr, int wc, int fr, int fq) const {
        const int row0 = u.row0 + wr * 64 + fr, col0 = u.col0 + wc * 32 + 8 * fq;
#pragma unroll
        for (int ai = 0; ai < 2; ++ai)
#pragma unroll
            for (int m = 0; m < 4; ++m) { bf16_t* rowp = X + (size_t)(row0 + ai * HALF + m * 16) * D + col0;
                u32x4 xo[2];
#pragma unroll
                for (int bj = 0; bj < 2; ++bj) xo[bj] = *(const u32x4*)(rowp + bj * HALF);
#pragma unroll
                for (int bj = 0; bj < 2; ++bj) { const f32x4 v0 = acc[ai][bj][m][0], v1 = acc[ai][bj][m][1]; const u32x4 x = xo[bj];
                    u32x4 w;
                    w.x = cvt_pk_bf16(fmaf(v0[0], asc, __uint_as_float(x.x << 16)), fmaf(v0[1], asc, __uint_as_float(x.x & 0xffff0000u))); w.y = cvt_pk_bf16(fmaf(v0[2], asc, __uint_as_float(x.y << 16)), fmaf(v0[3], asc, __uint_as_float(x.y & 0xffff0000u)));
                    w.z = cvt_pk_bf16(fmaf(v1[0], asc, __uint_as_float(x.z << 16)), fmaf(v1[1], asc, __uint_as_float(x.z & 0xffff0000u))); w.w = cvt_pk_bf16(fmaf(v1[2], asc, __uint_as_float(x.w << 16)), fmaf(v1[3], asc, __uint_as_float(x.w & 0xffff0000u)));
                    *(u32x4*)(rowp + bj * HALF) = w; } }
    }
};

template <class Epi, class Sched, bool ALIGN_EPI = true, bool FP8 = false, int SCA = 127, int SCB = 127, bool PEEL = true>
__device__ __forceinline__ void gemm_phase(LAS unsigned char* lds, const int K, const Sched& S, const Epi& E, const int tid) {
    const int wid = __builtin_amdgcn_readfirstlane(tid >> 6), lane = tid & 63, wr = wid >> 2, wc = wid & 3, fr = lane & 15, fq = lane >> 4;
    const int nt = K / BK;
    unsigned voffA[2], voffB[2], voffB1[2];
#pragma unroll
    for (int i = 0; i < 2; ++i) { int R, C; if constexpr (FP8) stage_rc8(tid * 16 + i * 8192, R, C); else stage_rc(tid * 16 + i * 8192, R, C); const int Rb = Epi::PERM ? ((R & ~31) + perm32(R & 31)) : R;
        voffA[i] = (unsigned)(R * K + C) * 2u; voffB[i] = (unsigned)(Rb * K + C) * 2u; voffB1[i] = voffB[i];
        if constexpr (Epi::PERM16) {
            const int c0_ = 64 * (R >> 5) + 16 * ((R >> 2) & 3) + 4 * ((R >> 4) & 1) + (R & 3);
            voffB[i] = (unsigned)(c0_ * K + C) * 2u; voffB1[i] = (unsigned)((c0_ + 8) * K + C) * 2u; } }
    int gR[2]; unsigned gC2[2];
#pragma unroll
    for (int i = 0; i < 2; ++i) { int R, C; if constexpr (FP8) stage_rc8(tid * 16 + i * 8192, R, C); else stage_rc(tid * 16 + i * 8192, R, C); gR[i] = R; gC2[i] = (unsigned)C * 2u; }
    const size_t kstep = (size_t)(BK * 2);
    const size_t hstep = (size_t)HALF * K * 2;
    const size_t hstepB = Epi::PERM16 ? (size_t)0 : hstep;
    const unsigned ldsw = (unsigned)wid * 1024u;
    const int aoff = lds_byte(wr * 64 + fr, fq * 8), boff = lds_byte(wc * 32 + fr, fq * 8);
#define PG8_SA(b, h) (((b) * 2 + (h)) * HTB)
#define PG8_SB(b, h) ((4 + (b) * 2 + (h)) * HTB)
#define PG8_STAGE(bufoff, gbase, voff) do { _Pragma("unroll") for (int _i = 0; _i < 2; ++_i) \
        __builtin_amdgcn_global_load_lds((const unsigned*)((const char*)(gbase) + (voff)[_i]), (LAS unsigned*)(lds + (bufoff) + ldsw + _i * 8192), 16, 0, 0); } while (0)
#define PG8_LD8(p_) __builtin_shufflevector(*(const LAS v4i_t*)(p_), *(const LAS v4i_t*)((p_) + 1024), 0, 1, 2, 3, 4, 5, 6, 7)
#define PG8_LDA(dst, b, h) do { if constexpr (FP8) { _Pragma("unroll") for (int m = 0; m < 4; ++m) dst##8[m] = PG8_LD8(lds + PG8_SA(b, h) + aoff + m * 2048); } \
        else { _Pragma("unroll") for (int m = 0; m < 4; ++m) _Pragma("unroll") for (int k = 0; k < 2; ++k) dst[m][k] = *(const LAS bf16x8*)(lds + PG8_SA(b, h) + aoff + m * 2048 + k * 1024); } } while (0)
#define PG8_LDB(dst, b, h) do { if constexpr (FP8) { _Pragma("unroll") for (int n = 0; n < 2; ++n) dst##8[n] = PG8_LD8(lds + PG8_SB(b, h) + boff + n * 2048); } \
        else { _Pragma("unroll") for (int n = 0; n < 2; ++n) _Pragma("unroll") for (int k = 0; k < 2; ++k) dst[n][k] = *(const LAS bf16x8*)(lds + PG8_SB(b, h) + boff + n * 2048 + k * 1024); } } while (0)
#define PG8_MMA(ai, bj, At, Bt) do { __builtin_amdgcn_s_setprio(1); \
        if constexpr (FP8) { _Pragma("unroll") for (int m = 0; m < 4; ++m) _Pragma("unroll") for (int n = 0; n < 2; ++n) \
            asm volatile("v_mfma_f32_16x16x128_f8f6f4 %0, %1, %2, %0" : "+v"(acc[ai][bj][m][n]) : "v"(Bt##8[n]), "v"(At##8[m])); } \
        else { _Pragma("unroll") for (int k = 0; k < 2; ++k) _Pragma("unroll") for (int m = 0; m < 4; ++m) _Pragma("unroll") for (int n = 0; n < 2; ++n) \
            asm volatile("v_mfma_f32_16x16x32_bf16 %0, %1, %2, %0" : "+v"(acc[ai][bj][m][n]) : "v"(Bt[n][k]), "v"(At[m][k])); } \
        __builtin_amdgcn_s_setprio(0); } while (0)
#define PG8_WAIT_V(n) asm volatile("s_waitcnt vmcnt(" #n ")" ::: "memory")
#define PG8_WAIT_L(n) asm volatile("s_waitcnt lgkmcnt(" #n ")" ::: "memory")
#define PG8_BAR __builtin_amdgcn_s_barrier()
#define PG8_SCHED __builtin_amdgcn_sched_barrier(0)
    Unit cur, nxt; int ui = 0;
    if (!S.next(0, cur)) return;
    f32x4 acc[2][2][4][2];
#pragma unroll
    for (int a = 0; a < 2; ++a)
#pragma unroll
        for (int b = 0; b < 2; ++b)
#pragma unroll
            for (int m = 0; m < 4; ++m)
#pragma unroll
                for (int n = 0; n < 2; ++n) { acc[a][b][m][n] = (f32x4){0.f, 0.f, 0.f, 0.f}; asm volatile("" : "+v"(acc[a][b][m][n])); }
    bf16x8 At[4][2], B0[2][2], B1[2][2];
    typedef int v8i_t __attribute__((ext_vector_type(8))); typedef int v4i_t __attribute__((ext_vector_type(4)));
    v8i_t At8[4], B08[2], B18[2];
    const char* cA = cur.A; const char* cB = cur.B;
    unsigned cvo[2][2], nvo[2][2];
#define PG8_GOFF(vo, un) do { _Pragma("unroll") for (int h_ = 0; h_ < 2; ++h_) _Pragma("unroll") for (int i_ = 0; i_ < 2; ++i_) { const int row_ = gR[i_] + HALF * h_; \
        const int tok_ = (row_ < (un).nvalid) ? (un).toks[row_] : 0; vo[h_][i_] = (unsigned)tok_ * (unsigned)(K * 2) + gC2[i_]; } } while (0)
    if constexpr (Sched::GATHER) { PG8_GOFF(cvo, cur); }
    if constexpr (Sched::GATHER) { PG8_STAGE(PG8_SB(0, 0), cB, voffB); PG8_STAGE(PG8_SB(0, 1), cB + hstepB, voffB1); PG8_STAGE(PG8_SA(0, 0), cA, cvo[0]); PG8_STAGE(PG8_SA(0, 1), cA, cvo[1]); }
    else { PG8_STAGE(PG8_SB(0, 0), cB, voffB); PG8_STAGE(PG8_SB(0, 1), cB + hstepB, voffB1); PG8_STAGE(PG8_SA(0, 0), cA, voffA); PG8_STAGE(PG8_SA(0, 1), cA + hstep, voffA); }
    if (wr == 1) PG8_BAR;
    PG8_WAIT_V(2); PG8_BAR;
    if constexpr (Sched::GATHER) { PG8_STAGE(PG8_SB(1, 0), cB + kstep, voffB); PG8_STAGE(PG8_SA(1, 0), cA + kstep, cvo[0]); PG8_STAGE(PG8_SB(1, 1), cB + hstepB + kstep, voffB1); }
    else { PG8_STAGE(PG8_SB(1, 0), cB + kstep, voffB); PG8_STAGE(PG8_SA(1, 0), cA + kstep, voffA); PG8_STAGE(PG8_SB(1, 1), cB + hstepB + kstep, voffB1); }
    PG8_WAIT_V(0); PG8_BAR;
    for (;;) {
        constexpr bool LATE_NEXT = PEEL && !Sched::GATHER;
        bool has_next = false; const char* nA = cA; const char* nB = cB;
        if constexpr (!LATE_NEXT) { has_next = S.next(ui + 1, nxt); nA = has_next ? nxt.A : cA; nB = has_next ? nxt.B : cB; }
        if constexpr (Sched::GATHER) {
            if (has_next) { PG8_GOFF(nvo, nxt); } else {
#pragma unroll
                for (int h_ = 0; h_ < 2; ++h_)
#pragma unroll
                    for (int i_ = 0; i_ < 2; ++i_) nvo[h_][i_] = cvo[h_][i_]; }
        }
#define PG8_TRIP(WV1) do { \
            const bool last = (t == nt - 2); \
            const char* b2 = last ? nB : cB + (size_t)(t + 2) * kstep; const char* b3 = b2 + kstep; \
            if constexpr (Sched::GATHER) { \
                const char* g1 = cA + (size_t)(t + 1) * kstep; const char* g2 = last ? cA : cA + (size_t)(t + 2) * kstep; const char* g3 = g2 + kstep; \
                unsigned x2[2][2]; \
                _Pragma("unroll") for (int h_ = 0; h_ < 2; ++h_) _Pragma("unroll") for (int i_ = 0; i_ < 2; ++i_) x2[h_][i_] = last ? nvo[h_][i_] : cvo[h_][i_]; \
                PG8_LDB(B0, 0, 0); PG8_LDB(B1, 0, 1); PG8_SCHED; PG8_LDA(At, 0, 0); PG8_STAGE(PG8_SA(1, 1), g1, cvo[1]); \
                PG8_WAIT_V(WV1); PG8_WAIT_L(0); PG8_BAR; PG8_MMA(0, 0, At, B0); PG8_MMA(0, 1, At, B1); PG8_BAR; PG8_SCHED; \
                PG8_LDA(At, 0, 1); PG8_STAGE(PG8_SB(0, 0), b2, voffB); PG8_STAGE(PG8_SB(0, 1), b2 + hstepB, voffB1); PG8_STAGE(PG8_SA(0, 0), g2, x2[0]); \
                PG8_WAIT_V(WV1); PG8_WAIT_L(0); PG8_BAR; PG8_MMA(1, 0, At, B0); PG8_MMA(1, 1, At, B1); PG8_BAR; PG8_SCHED; \
                PG8_LDB(B0, 1, 0); PG8_LDB(B1, 1, 1); PG8_SCHED; PG8_LDA(At, 1, 0); PG8_STAGE(PG8_SA(0, 1), g2, x2[1]); \
                PG8_WAIT_V(8); PG8_WAIT_L(0); PG8_BAR; PG8_MMA(0, 0, At, B0); PG8_MMA(0, 1, At, B1); PG8_BAR; PG8_SCHED; \
                PG8_LDA(At, 1, 1); PG8_STAGE(PG8_SB(1, 0), b3, voffB); PG8_STAGE(PG8_SB(1, 1), b3 + hstepB, voffB1); PG8_STAGE(PG8_SA(1, 0), g3, x2[0]); \
                PG8_WAIT_V(8); PG8_WAIT_L(0); PG8_BAR; PG8_MMA(1, 0, At, B0); PG8_MMA(1, 1, At, B1); PG8_BAR; PG8_SCHED; \
            } else { \
                const char* a1 = cA + (size_t)(t + 1) * kstep; const char* a2 = last ? nA : cA + (size_t)(t + 2) * kstep; const char* a3 = a2 + kstep; \
                PG8_LDB(B0, 0, 0); PG8_LDB(B1, 0, 1); PG8_SCHED; PG8_LDA(At, 0, 0); PG8_STAGE(PG8_SA(1, 1), a1 + hstep, voffA); \
                PG8_WAIT_V(WV1); PG8_WAIT_L(0); PG8_BAR; PG8_MMA(0, 0, At, B0); PG8_MMA(0, 1, At, B1); PG8_BAR; PG8_SCHED; \
                PG8_LDA(At, 0, 1); PG8_STAGE(PG8_SB(0, 0), b2, voffB); PG8_STAGE(PG8_SB(0, 1), b2 + hstepB, voffB1); PG8_STAGE(PG8_SA(0, 0), a2, voffA); \
                PG8_WAIT_V(WV1); PG8_WAIT_L(0); PG8_BAR; PG8_MMA(1, 0, At, B0); PG8_MMA(1, 1, At, B1); PG8_BAR; PG8_SCHED; \
                PG8_LDB(B0, 1, 0); PG8_LDB(B1, 1, 1); PG8_SCHED; PG8_LDA(At, 1, 0); PG8_STAGE(PG8_SA(0, 1), a2 + hstep, voffA); \
                PG8_WAIT_V(8); PG8_WAIT_L(0); PG8_BAR; PG8_MMA(0, 0, At, B0); PG8_MMA(0, 1, At, B1); PG8_BAR; PG8_SCHED; \
                PG8_LDA(At, 1, 1); PG8_STAGE(PG8_SB(1, 0), b3, voffB); PG8_STAGE(PG8_SB(1, 1), b3 + hstepB, voffB1); PG8_STAGE(PG8_SA(1, 0), a3, voffA); \
                PG8_WAIT_V(8); PG8_WAIT_L(0); PG8_BAR; PG8_MMA(1, 0, At, B0); PG8_MMA(1, 1, At, B1); PG8_BAR; PG8_SCHED; \
            } } while (0)
        if constexpr (PEEL) { int t = 0; PG8_TRIP(63); }
        if constexpr (LATE_NEXT) { has_next = S.next(ui + 1, nxt); nA = has_next ? nxt.A : cA; nB = has_next ? nxt.B : cB; }
#pragma unroll 1
        for (int t = PEEL ? 2 : 0; t < nt; t += 2) PG8_TRIP(8);
#undef PG8_TRIP
        if constexpr (ALIGN_EPI) { if (wr == 0) PG8_BAR; }
        if constexpr (PEEL) PG8_WAIT_V(0);
        {
            asm volatile("s_nop 15\n\ts_nop 15" ::: "memory");
#pragma unroll
            for (int a = 0; a < 2; ++a)
#pragma unroll
                for (int b = 0; b < 2; ++b)
#pragma unroll
                    for (int m = 0; m < 4; ++m)
#pragma unroll
                        for (int n = 0; n < 2; ++n) asm volatile("" : "+v"(acc[a][b][m][n]));
        }
        E(acc, cur, wr, wc, fr, fq);
        if (!has_next) break;
#pragma unroll
        for (int a = 0; a < 2; ++a)
#pragma unroll
            for (int b = 0; b < 2; ++b)
#pragma unroll
                for (int m = 0; m < 4; ++m)
#pragma unroll
                    for (int n = 0; n < 2; ++n) { acc[a][b][m][n] = (f32x4){0.f, 0.f, 0.f, 0.f}; asm volatile("" : "+v"(acc[a][b][m][n])); }
        cur = nxt; cA = nA; cB = nB; ++ui;
        if constexpr (Sched::GATHER) {
#pragma unroll
            for (int h_ = 0; h_ < 2; ++h_)
#pragma unroll
                for (int i_ = 0; i_ < 2; ++i_) cvo[h_][i_] = nvo[h_][i_]; }
        if constexpr (ALIGN_EPI) { if (wr == 1) PG8_BAR; }
    }
    PG8_WAIT_V(0);
    if constexpr (!ALIGN_EPI) { if (wr == 0) PG8_BAR; }
    PG8_BAR;
#undef PG8_GOFF
#undef PG8_SA
#undef PG8_SB
#undef PG8_STAGE
#undef PG8_LDA
#undef PG8_LD8
#undef PG8_LDB
#undef PG8_MMA
#undef PG8_WAIT_V
#undef PG8_WAIT_L
#undef PG8_BAR
#undef PG8_SCHED
}
}

constexpr size_t MiB = 1u << 20;
constexpr size_t WS_CTL = 0, CTL_ZERO_BYTES = 1 * MiB;
constexpr size_t WS_MISC = 1 * MiB;
constexpr size_t MISC_LAM = 0;
constexpr size_t MISC_LB = 1024;
constexpr size_t MISC_WRB = 64 * 1024;
constexpr size_t MISC_ROPE = 1 * MiB;
constexpr size_t MISC_TOKPOS = 6 * MiB;
constexpr size_t MISC_TOKGATE = 7 * MiB;
constexpr size_t MISC_TOKSLOT = 8 * MiB;
constexpr size_t MISC_TOKRSTD = 9 * MiB;
constexpr size_t MISC_SLOTRSTD = 10 * MiB;
constexpr size_t MISC_RSTDMIX = 11 * MiB;
constexpr size_t WS_WIN = 17 * MiB;
constexpr size_t WS_WOUT = 30 * MiB;
constexpr size_t WS_WGU = 34 * MiB;
constexpr size_t WS_WD = 162 * MiB;
constexpr size_t WS_U = 226 * MiB;
constexpr size_t WS_XG = WS_U, WS_ACT = WS_U + 272 * MiB;
constexpr size_t WS_X8 = WS_U + 344 * MiB;
constexpr size_t WS_X8B = 642 * MiB;
constexpr size_t WS_MIX = 642 * MiB;
constexpr size_t WS_XN = 770 * MiB;
constexpr size_t WS_LIST = 898 * MiB;
constexpr size_t WS_LRS = 906 * MiB;
constexpr size_t WS_END = 962 * MiB;
static_assert((size_t)CAP * 1024 * 2 <= 272 * MiB && (size_t)CAP * 512 * 2 <= 136 * MiB && (size_t)M * DIN * 2 <= 416 * MiB, "ws map");
constexpr int CW_BAR = 4096;
constexpr int CW_Q = 8192;
constexpr int CW_CNT = 16384;

constexpr int RING_OFF = 0, RING_BYTES = 131072;
constexpr int LDSCTL_OFF = RING_BYTES, MISC_OFF = LDSCTL_OFF + 320;
constexpr int TAB_OFF = LDSCTL_OFF + 1024;
constexpr int LDS_BYTES = 147456;

typedef unsigned short bf16;
typedef unsigned v4u __attribute__((ext_vector_type(4)));
typedef unsigned v2u __attribute__((ext_vector_type(2)));
typedef float f32x4 __attribute__((ext_vector_type(4)));
typedef float f32x2 __attribute__((ext_vector_type(2)));
typedef float f32x16 __attribute__((ext_vector_type(16)));
typedef short bf16x8 __attribute__((ext_vector_type(8)));
typedef short s16x4 __attribute__((ext_vector_type(4)));
typedef GAS unsigned gu32;
#define RLX_AGENT __ATOMIC_RELAXED, __HIP_MEMORY_SCOPE_AGENT
#define LDS_WAIT() asm volatile("s_waitcnt lgkmcnt(0)" ::: "memory")
#define VM_WAIT() asm volatile("s_waitcnt vmcnt(0)" ::: "memory")
typedef float f32x2_t __attribute__((ext_vector_type(2))); typedef __bf16 bf16x2_t __attribute__((ext_vector_type(2)));
__device__ __forceinline__ unsigned pk2(float lo, float hi) { f32x2_t v = {lo, hi}; bf16x2_t b = __builtin_convertvector(v, bf16x2_t); return __builtin_bit_cast(unsigned, b); }
__device__ __forceinline__ float bflo(unsigned w) { return __uint_as_float(w << 16); }
__device__ __forceinline__ float bfhi(unsigned w) { return __uint_as_float(w & 0xffff0000u); }
constexpr float MIXSC = 4.0f;
__device__ __forceinline__ float fp8c(float x) { return __builtin_amdgcn_fmed3f(x, -440.0f, 440.0f); }
__device__ __forceinline__ v2u pk8_fp8(const float (&v)[8]) { int w0 = 0, w1 = 0;
    w0 = __builtin_amdgcn_cvt_pk_fp8_f32(fp8c(v[0] * MIXSC), fp8c(v[1] * MIXSC), w0, false); w0 = __builtin_amdgcn_cvt_pk_fp8_f32(fp8c(v[2] * MIXSC), fp8c(v[3] * MIXSC), w0, true);
    w1 = __builtin_amdgcn_cvt_pk_fp8_f32(fp8c(v[4] * MIXSC), fp8c(v[5] * MIXSC), w1, false); w1 = __builtin_amdgcn_cvt_pk_fp8_f32(fp8c(v[6] * MIXSC), fp8c(v[7] * MIXSC), w1, true);
    return (v2u){(unsigned)w0, (unsigned)w1}; }
__device__ __forceinline__ float fsigmoid(float z) { return __builtin_amdgcn_rcpf(1.0f + __builtin_amdgcn_exp2f(-1.4426950408889634f * z)); }

#define XB_TMO      128
#define XB_XCNT(j)  (256  + 64 * (j))
#define XB_XSUB(j)  (1280 + 64 * (j))
#define XB_XGEN(j)  (2304 + 64 * (j))
#define XB_TOP      3328
#define XB_TOPGEN   3392
#define XCD_BAR_WORDS 3456
#define XB_SPIN_CAP (1u << 18)
__device__ __forceinline__ unsigned xb_ld(unsigned* p)              { return __hip_atomic_load(p, __ATOMIC_RELAXED, __HIP_MEMORY_SCOPE_AGENT); }
__device__ __forceinline__ unsigned xb_add(unsigned* p, unsigned v) { return __hip_atomic_fetch_add(p, v, __ATOMIC_RELAXED, __HIP_MEMORY_SCOPE_AGENT); }
__device__ __forceinline__ unsigned xb_xcc_id() { return (unsigned)__builtin_amdgcn_s_getreg((3 << 11) | 20) & 0xFu; }
#define XB_SPIN(cond, bar) do { unsigned _sp = 0; while (cond) { __builtin_amdgcn_s_sleep(1); \
    if ((++_sp & 255u) == 0u) { if (xb_ld(&(bar)[XB_TMO])) break; if (_sp > XB_SPIN_CAP) { atomicAdd(&(bar)[XB_TMO], 1u); break; } } } } while (0)
struct XcdBarrier { unsigned* bar; unsigned x; volatile LAS unsigned* st; };
__device__ __forceinline__ XcdBarrier xcd_barrier_post(unsigned* bar, volatile LAS unsigned* st) {
    XcdBarrier b; b.bar = bar; b.x = xb_xcc_id(); b.st = st;
    if (threadIdx.x == 0) (void)xb_add(&bar[XB_XCNT(b.x)], 1u);
    return b;
}
__device__ __forceinline__ void xcd_barrier_complete(unsigned* bar, unsigned x, unsigned& nloc, unsigned& nx) {
    const unsigned G = gridDim.x * gridDim.y * gridDim.z;
    unsigned sum, cnt, mine, sp = 0u;
    for (;;) {
        sum = 0u; cnt = 0u; mine = 0u;
#pragma unroll
        for (unsigned j = 0; j < 16; ++j) { const unsigned c = xb_ld(&bar[XB_XCNT(j)]); sum += c; cnt += (c > 0u) ? 1u : 0u; mine = (j == x) ? c : mine; }
        if (sum == G) break;
        __builtin_amdgcn_s_sleep(1);
        if ((++sp & 255u) == 0u) { if (xb_ld(&bar[XB_TMO])) break; if (sp > XB_SPIN_CAP) { atomicAdd(&bar[XB_TMO], 1u); break; } }
    }
    nloc = mine > 0u ? mine : 1u; nx = cnt > 0u ? cnt : 1u;
}
__device__ __forceinline__ void xcd_barrier(const XcdBarrier& b) {
    asm volatile("s_waitcnt vmcnt(0)" ::: "memory");
    __syncthreads();
    if (threadIdx.x == 0) {
        unsigned* bar = b.bar; asm volatile("" : "+s"(bar));
        __builtin_amdgcn_s_waitcnt(0);
        unsigned nloc = b.st[0], nx = b.st[1];
        if (nloc == 0u) { xcd_barrier_complete(bar, b.x, nloc, nx); b.st[0] = nloc; b.st[1] = nx; }
        const unsigned old = xb_add(&bar[XB_XSUB(b.x)], 1u);
        const unsigned gen = old / nloc;
        if (old + 1u == (gen + 1u) * nloc) {
            __builtin_amdgcn_fence(__ATOMIC_RELEASE, "agent");
            asm volatile("s_waitcnt vmcnt(0)" ::: "memory");
            const unsigned og = xb_add(&bar[XB_TOP], 1u);
            const unsigned tg = og / nx;
            if (og + 1u == (tg + 1u) * nx) xb_add(&bar[XB_TOPGEN], 1u);
            else XB_SPIN(xb_ld(&bar[XB_TOPGEN]) == tg, bar);
            __builtin_amdgcn_fence(__ATOMIC_ACQUIRE, "agent");
            xb_add(&bar[XB_XGEN(b.x)], 1u);
            asm volatile("s_waitcnt vmcnt(0)" ::: "memory");
        } else {
            XB_SPIN(xb_ld(&bar[XB_XGEN(b.x)]) == gen, bar);
            __builtin_amdgcn_fence(__ATOMIC_ACQUIRE, "agent");
            asm volatile("s_waitcnt vmcnt(0)" ::: "memory");
        }
    }
    __syncthreads();
}

struct Args { const float* in[23]; float* out; unsigned char* ws; int ph_lo, ph_hi; };
struct Frame {
    LAS unsigned char* lds;
    volatile LAS unsigned* MISC;
    gu32* ctl;
    int tid, lane, wave;
    int vcu, G, bx;
    float* out; unsigned char* ws;
};
__device__ __forceinline__ float wave_sum(float v) {
#pragma unroll
    for (int o = 1; o < 64; o <<= 1) v += __shfl_xor(v, o);
    return v;
}

__device__ __forceinline__ void wt_load(const float* W, int N, int k0, int n0, const float* kscale, int lane, f32x4 (&wv)[8], float (&kv)[8]) {
    const float* p = W + (size_t)(k0 + (lane >> 3)) * N + n0 + 4 * (lane & 7);
#pragma unroll
    for (int j = 0; j < 8; ++j) wv[j] = *(const GAS f32x4*)(p + (size_t)(8 * j) * N);
#pragma unroll
    for (int j = 0; j < 8; ++j) kv[j] = kscale ? kscale[k0 + 8 * j + (lane >> 3)] : 1.0f;
}
__device__ __forceinline__ void wt_to_lds(const f32x4 (&wv)[8], const float (&kv)[8], float wmul, LAS float* scr, int lane) {
#pragma unroll
    for (int j = 0; j < 8; ++j) { LAS float* q = scr + (8 * j + (lane >> 3)) * 33 + 4 * (lane & 7); const float m = kv[j] * wmul; q[0] = wv[j].x * m; q[1] = wv[j].y * m; q[2] = wv[j].z * m; q[3] = wv[j].w * m; }
    LDS_WAIT(); asm volatile("" ::: "memory");
}
__device__ __forceinline__ void wt_store_bf16(bf16* WT, int K, int dst_row0, int k0, LAS float* scr, int lane) {
    const int c = lane & 7;
#pragma unroll
    for (int j = 0; j < 4; ++j) { const int n = (lane >> 3) + 8 * j; const LAS float* s = scr + (8 * c) * 33 + n;
        v4u o; o.x = pk2(s[0 * 33], s[1 * 33]); o.y = pk2(s[2 * 33], s[3 * 33]); o.z = pk2(s[4 * 33], s[5 * 33]); o.w = pk2(s[6 * 33], s[7 * 33]);
        *(GAS v4u*)(WT + (size_t)(dst_row0 + n) * K + k0 + 8 * c) = o; }
    LDS_WAIT(); asm volatile("" ::: "memory");
}
__device__ __forceinline__ void wt_store_fp8(unsigned char* WT, int K, int dst_row0, int k0, LAS float* scr, int lane) {
    const int n = lane & 31, kh = lane >> 5; const LAS float* sp = scr + (32 * kh) * 33 + n;
    unsigned w[8];
#pragma unroll
    for (int q = 0; q < 8; ++q) { int t = 0; t = __builtin_amdgcn_cvt_pk_fp8_f32(sp[(4 * q) * 33], sp[(4 * q + 1) * 33], t, false); t = __builtin_amdgcn_cvt_pk_fp8_f32(sp[(4 * q + 2) * 33], sp[(4 * q + 3) * 33], t, true); w[q] = (unsigned)t; }
    unsigned char* dst = WT + (size_t)(dst_row0 + n) * K + k0 + 32 * kh;
    *(GAS v4u*)dst = (v4u){w[0], w[1], w[2], w[3]}; *(GAS v4u*)(dst + 16) = (v4u){w[4], w[5], w[6], w[7]};
    LDS_WAIT(); asm volatile("" ::: "memory");
}
__device__ __forceinline__ void p0_transpose_item(const float* W, int K, int N, bf16* WT, int dst_row0, int k0, int n0, LAS float* scr, int lane, const float* kscale = nullptr) {
    f32x4 wv[8]; float kv[8];
    wt_load(W, N, k0, n0, kscale, lane, wv, kv); wt_to_lds(wv, kv, 1.0f, scr, lane); wt_store_bf16(WT, K, dst_row0, k0, scr, lane);
}
__device__ __forceinline__ void p0_transpose_item8(const float* W, int K, int N, unsigned char* WT, int dst_row0, int k0, int n0, LAS float* scr, int lane, const float* kscale, float wmul) {
    f32x4 wv[8]; float kv[8];
    wt_load(W, N, k0, n0, kscale, lane, wv, kv); wt_to_lds(wv, kv, wmul, scr, lane); wt_store_fp8(WT, K, dst_row0, k0, scr, lane);
}
__device__ __forceinline__ void row_to_bf16_rstd(const float* xrow, bf16* orow, float* rs, int lane) {
    const GAS f32x4* xr = (const GAS f32x4*)xrow + 2 * lane;
    f32x4 v[4]; float s = 0.f;
#pragma unroll
    for (int j = 0; j < 2; ++j) { v[2 * j] = xr[128 * j]; v[2 * j + 1] = xr[128 * j + 1]; }
#pragma unroll
    for (int j = 0; j < 4; ++j) s += (v[j].x * v[j].x + v[j].y * v[j].y) + (v[j].z * v[j].z + v[j].w * v[j].w);
    const float rstd = 1.0f / sqrtf(wave_sum(s) * (1.f / D) + EPS);
    GAS v4u* o16 = (GAS v4u*)orow + lane;
#pragma unroll
    for (int j = 0; j < 2; ++j) o16[64 * j] = (v4u){pk2(v[2 * j].x, v[2 * j].y), pk2(v[2 * j].z, v[2 * j].w), pk2(v[2 * j + 1].x, v[2 * j + 1].y), pk2(v[2 * j + 1].z, v[2 * j + 1].w)};
    if (lane == 0) *rs = rstd;
}
constexpr int I_WIN = 16 * 104, I_WOUT = 16 * 32, I_G = 16 * 16, I_D = 8 * 32;
constexpr int ITEMS_PER_LAYER = I_WIN + I_WOUT + 2 * 32 * I_G + 32 * I_D;
__device__ __forceinline__ void weight_item(const Args& A, unsigned char* ws, int l, int r, LAS float* scr, int lane) {
    if (r < I_WIN) { const int kb = r / 104, nb = r % 104;
        if (l == 0) p0_transpose_item(A.in[3], D, DIN, (bf16*)(ws + WS_WIN), 32 * nb, 64 * kb, 32 * nb, scr, lane, A.in[2]);
        else p0_transpose_item8(A.in[3] + (size_t)l * D * DIN, D, DIN, ws + WS_WIN + (size_t)DIN * D * 2, 32 * nb, 64 * kb, 32 * nb, scr, lane, A.in[2] + l * D, 32.0f);
        return; } r -= I_WIN;
    if (r < I_WOUT) { const int kb = r / 32, nb = r % 32;
        if (l == 0) p0_transpose_item(A.in[14], D, D, (bf16*)(ws + WS_WOUT), 32 * nb, 64 * kb, 32 * nb, scr, lane);
        else p0_transpose_item8(A.in[14] + (size_t)l * D * D, D, D, ws + WS_WOUT + 2 * MiB, 32 * nb, 64 * kb, 32 * nb, scr, lane, nullptr, 32.0f);
        return; } r -= I_WOUT;
    if (r < 32 * I_G) { const int le = l * 32 + r / I_G, q = r % I_G, kb = q / 16, nb = q % 16, n0 = 32 * nb;
        p0_transpose_item8(A.in[20] + (size_t)le * D * DEXP, D, DEXP, ws + WS_WGU + (size_t)le * D * D, (n0 >> 7) * 256 + (n0 & 127), 64 * kb, n0, scr, lane, A.in[15] + l * D, 32.0f); return; } r -= 32 * I_G;
    if (r < 32 * I_G) { const int le = l * 32 + r / I_G, q = r % I_G, kb = q / 16, nb = q % 16, n0 = 32 * nb;
        p0_transpose_item8(A.in[21] + (size_t)le * D * DEXP, D, DEXP, ws + WS_WGU + (size_t)le * D * D, (n0 >> 7) * 256 + 128 + (n0 & 127), 64 * kb, n0, scr, lane, A.in[15] + l * D, 32.0f); return; } r -= 32 * I_G;
    { const int le = l * 32 + r / I_D, q = r % I_D, kb = q / 32, nb = q % 32;
        p0_transpose_item8(A.in[22] + (size_t)le * DEXP * D, DEXP, D, ws + WS_WD + (size_t)le * D * DEXP, 32 * nb, 64 * kb, 32 * nb, scr, lane, nullptr, 16.0f); }
}
struct WItem { const float* W; const float* ks; unsigned char* dst; int N, Kp, k0, n0, drow, kind; float wmul; };
__device__ __forceinline__ void witem_desc(const Args& A, unsigned char* ws, int it, WItem& d) {
    constexpr int N_DEF_ = (ITEMS_PER_LAYER - I_WIN) + ITEMS_PER_LAYER;
    d.kind = -1; d.W = A.in[3]; d.ks = nullptr; d.dst = ws; d.N = 0; d.Kp = 0; d.k0 = 0; d.n0 = 0; d.drow = 0; d.wmul = 1.0f;
    int l, r;
    if (it < ITEMS_PER_LAYER - I_WIN) { l = 0; r = I_WIN + it; } else if (it < N_DEF_) { l = 1; r = it - (ITEMS_PER_LAYER - I_WIN); } else return;
    if (r < I_WIN) { const int kb = r / 104, nb = r % 104; d.N = DIN; d.Kp = D; d.k0 = 64 * kb; d.n0 = 32 * nb; d.drow = 32 * nb; d.ks = A.in[2] + l * D;
        if (l == 0) { d.kind = 0; d.W = A.in[3]; d.dst = ws + WS_WIN; } else { d.kind = 1; d.W = A.in[3] + (size_t)l * D * DIN; d.dst = ws + WS_WIN + (size_t)DIN * D * 2; d.wmul = 32.0f; }
        return; }
    r -= I_WIN;
    if (r < I_WOUT) { const int kb = r / 32, nb = r % 32; d.N = D; d.Kp = D; d.k0 = 64 * kb; d.n0 = 32 * nb; d.drow = 32 * nb;
        if (l == 0) { d.kind = 0; d.W = A.in[14]; d.dst = ws + WS_WOUT; } else { d.kind = 1; d.W = A.in[14] + (size_t)l * D * D; d.dst = ws + WS_WOUT + 2 * MiB; d.wmul = 32.0f; }
        return; }
    r -= I_WOUT;
    if (r < 2 * 32 * I_G) { const int up = (r >= 32 * I_G) ? 1 : 0; r -= up * 32 * I_G;
        const int le = l * 32 + r / I_G, q = r % I_G, kb = q / 16, nb = q % 16, n0 = 32 * nb;
        d.kind = 1; d.W = (up ? A.in[21] : A.in[20]) + (size_t)le * D * DEXP; d.N = DEXP; d.Kp = D; d.dst = ws + WS_WGU + (size_t)le * D * D; d.drow = (n0 >> 7) * 256 + up * 128 + (n0 & 127); d.k0 = 64 * kb; d.n0 = n0;
        d.ks = A.in[15] + l * D; d.wmul = 32.0f; return; }
    r -= 2 * 32 * I_G;
    { const int le = l * 32 + r / I_D, q = r % I_D, kb = q / 32, nb = q % 32;
      d.kind = 1; d.W = A.in[22] + (size_t)le * DEXP * D; d.N = D; d.Kp = DEXP; d.dst = ws + WS_WD + (size_t)le * D * DEXP; d.drow = 32 * nb; d.k0 = 64 * kb; d.n0 = 32 * nb; d.wmul = 16.0f; }
}
__device__ __forceinline__ void witem_finish(const WItem& d, const f32x4 (&wv)[8], const float (&kv)[8], LAS float* scr, int lane) {
    if (d.kind < 0) return;
    wt_to_lds(wv, kv, d.wmul, scr, lane);
    if (d.kind == 0) wt_store_bf16((bf16*)d.dst, d.Kp, d.drow, d.k0, scr, lane); else wt_store_fp8(d.dst, d.Kp, d.drow, d.k0, scr, lane);
}
__device__ __forceinline__ void p0_prologue(const Args& A, Frame& F) {
    LAS float* scr = (LAS float*)(F.lds + RING_OFF + F.wave * 16384);
    const int gw = F.vcu * 8 + F.wave, NGW = F.G * 8;
    unsigned char* ws = F.ws;
    for (int it = gw; it < I_WIN; it += NGW) weight_item(A, ws, 0, it, scr, F.lane);
    const int gt = F.vcu * 512 + F.tid, NGT = F.G * 512;
    { bf16* WrB = (bf16*)(ws + WS_MISC + MISC_WRB);
      for (int i = gt; i < 2 * 64 * 1024; i += NGT) { const int l = i / (64 * 1024), o = (i / 1024) % 64, k = i % 1024;
          float w = (o < 32) ? A.in[18][((size_t)l * D + k) * 32 + o] : (o < 36 ? A.in[16][((size_t)l * D + k) * 4 + (o - 32)] : 0.f);
          w *= A.in[15][l * D + k];
          const unsigned hb = pk2(w, 0.f) & 0xffffu; const float lo = w - __uint_as_float(hb << 16);
          const size_t base = (size_t)(l * 16 + (k >> 6)) * 8192 + (size_t)((k & 63) >> 3) * 256 + (o & 31) * 8 + (k & 7);
          WrB[base + (size_t)((o >> 5) * 2 + 0) * 2048] = (bf16)hb; WrB[base + (size_t)((o >> 5) * 2 + 1) * 2048] = (bf16)(pk2(lo, 0.f) & 0xffffu); } }
    { float* rope = (float*)(ws + WS_MISC + MISC_ROPE); const int* pos = (const int*)A.in[1];
      for (int i = gt; i < M * 8; i += NGT) { const int m = i >> 3, f = i & 7;
          const float invf = exp2f(-(float)f * (18.931568569324174f / 8.0f));
          const float ang = (float)pos[m] * invf; float sn, cs; sincosf(ang, &sn, &cs);
          rope[(size_t)m * 16 + f] = cs; rope[(size_t)m * 16 + 8 + f] = sn; } }
    if (gt < 2) { const int l = gt; float s1 = 0.f, s2 = 0.f;
        for (int i = 0; i < 64; ++i) { s1 += A.in[6][l * 64 + i] * A.in[7][l * 64 + i]; s2 += A.in[8][l * 64 + i] * A.in[9][l * 64 + i]; }
        const float lam_init = 0.8f - 0.6f * expf(-0.3f * (float)l);
        ((float*)(ws + WS_MISC + MISC_LAM))[l] = expf(s1) - expf(s2) + lam_init; }
    if (gt >= 512 && gt < 512 + 256) { const int j = gt - 512; const float h0 = A.in[11][j], h1 = A.in[11][256 + j];
        float* lb = (float*)(ws + WS_MISC + MISC_LB); lb[j] = 0.f; lb[256 + j] = 1.0f / (1.0f + expf(h0 - h1)); }
    for (int m = gw; m < M; m += NGW) row_to_bf16_rstd(A.in[0] + (size_t)m * D, (bf16*)(ws + WS_XN) + (size_t)m * D, (float*)(ws + WS_MISC + MISC_RSTDMIX) + m, F.lane);
}

__device__ __forceinline__ void conv_unit(const Args& A, Frame& F, int l, int cu) {
    const int lane = F.lane, ch = (lane & 31) * 8, half = lane >> 5;
    const bf16* u = (const bf16*)(F.ws + WS_U); bf16* mix = (bf16*)(F.ws + WS_MIX);
    const float* cw = A.in[13] + (size_t)l * 3 * 256 + ch;
    float w0[8], w1[8], w2[8];
#pragma unroll
    for (int j = 0; j < 8; ++j) { w0[j] = cw[j]; w1[j] = cw[256 + j]; w2[j] = cw[512 + j]; }
    const int m0 = cu * 256 + F.wave * 32 + half;
#define CV_H(dst, rowp) do { const v4u c_ = *(const GAS v4u*)((rowp) + CC + ch), x_ = *(const GAS v4u*)((rowp) + CX + ch); const unsigned cw_[4] = {c_.x, c_.y, c_.z, c_.w}, xw_[4] = {x_.x, x_.y, x_.z, x_.w}; \
        _Pragma("unroll") for (int q = 0; q < 4; ++q) { dst[2 * q] = bflo(cw_[q]) * bflo(xw_[q]); dst[2 * q + 1] = bfhi(cw_[q]) * bfhi(xw_[q]); } } while (0)
    for (int i = 0; i < 16; ++i) {
        const int m = m0 + 2 * i; const bf16* row = u + (size_t)m * DIN;
        const int s = m & (SEQ - 1);
        const v4u cbv = *(const GAS v4u*)(row + CB + ch);
        float h0[8], h1[8], h2[8];
#pragma unroll
        for (int j = 0; j < 8; ++j) { h0[j] = 0.f; h1[j] = 0.f; }
        CV_H(h2, row);
        if (s >= 1) CV_H(h1, row - DIN);
        if (s >= 2) CV_H(h0, row - 2 * DIN);
        const unsigned bw[4] = {cbv.x, cbv.y, cbv.z, cbv.w};
        float y[8];
#pragma unroll
        for (int q = 0; q < 4; ++q) { y[2 * q] = bflo(bw[q]) * (w0[2 * q] * h0[2 * q] + w1[2 * q] * h1[2 * q] + w2[2 * q] * h2[2 * q]); y[2 * q + 1] = bfhi(bw[q]) * (w0[2 * q + 1] * h0[2 * q + 1] + w1[2 * q + 1] * h1[2 * q + 1] + w2[2 * q + 1] * h2[2 * q + 1]); }
        if (l == 0) *(GAS v4u*)(mix + (size_t)m * D + 768 + ch) = (v4u){pk2(y[0], y[1]), pk2(y[2], y[3]), pk2(y[4], y[5]), pk2(y[6], y[7])};
        else *(GAS v2u*)((unsigned char*)mix + (size_t)m * D + 768 + ch) = pk8_fp8(y);
    }
#undef CV_H
}

__device__ __forceinline__ int crow(int r, int hi) { return (r & 3) + 8 * (r >> 2) + 4 * hi; }
typedef short v4i16_t __attribute__((ext_vector_type(4)));
__device__ __forceinline__ s16x4 vtr(const LAS unsigned char* p) { return __builtin_bit_cast(s16x4, __builtin_amdgcn_ds_read_tr16_b64_v4i16((LAS v4i16_t*)p)); }
constexpr int XS = 132;
__device__ __forceinline__ void attn_unit(Frame& F, const bf16* u, bf16* mix, int b, int h, int rb, float lam, float oscale, const float* subg, const bool mix8) {
    const int lane = F.lane, r32 = lane & 31, hi = lane >> 5, wid = F.wave, rg = wid & 3, comp = wid >> 2;
    const size_t rowb = (size_t)b * SEQ; const int t0 = rb * 128;
    const int NT = 2 * rb + 2, ntw = 2 * rb + (rg >> 1) + 1;
    LAS unsigned char* lds = F.lds;
    const int kr = 8 * wid + (lane >> 3);
    const bf16* ksrc0 = u + (rowb + kr) * DIN + AK + h * 128 + (((lane & 7) ^ ((kr >> 1) & 7)) * 8);
    const bf16* ksrc1 = ksrc0 + 64;
    const int vr = 8 * wid + (lane >> 4);
    const bf16* vsrcA = u + (rowb + vr) * DIN + AV + h * 128 + ((((lane & 15) >> 2) ^ (vr & 3)) * 32) + (lane & 3) * 8;
    const bf16* vsrcB = vsrcA + 4 * DIN;
#define ATT_DMA_K(j, s) do { const size_t go = (size_t)(j) * 64 * DIN; LAS unsigned char* sb = lds + (s) * 16384 + wid * 1024; \
        __builtin_amdgcn_global_load_lds((const unsigned*)(ksrc0 + go), (LAS unsigned*)(sb), 16, 0, 0); \
        __builtin_amdgcn_global_load_lds((const unsigned*)(ksrc1 + go), (LAS unsigned*)(sb + 8192), 16, 0, 0); } while (0)
#define ATT_DMA_V(j, s) do { const size_t go = (size_t)(j) * 64 * DIN; LAS unsigned char* sb = lds + 65536 + (s) * 16384 + wid * 2048; \
        __builtin_amdgcn_global_load_lds((const unsigned*)(vsrcA + go), (LAS unsigned*)(sb), 16, 0, 0); \
        __builtin_amdgcn_global_load_lds((const unsigned*)(vsrcB + go), (LAS unsigned*)(sb + 1024), 16, 0, 0); } while (0)
#define ATT_KRD(s) do { const LAS unsigned char* Kb = lds + (s) * 16384 + comp * 8192 + r32 * 128; \
        _Pragma("unroll") for (int d0 = 0; d0 < 4; ++d0) { kf[2 * d0] = *(const LAS bf16x8*)(Kb + koff[d0]); kf[2 * d0 + 1] = *(const LAS bf16x8*)(Kb + koff[d0] + 4096); } \
        __builtin_amdgcn_sched_barrier(0); } while (0)
#define ATT_QKM(P0, P1) do { \
        _Pragma("unroll") for (int r = 0; r < 16; ++r) { P0[r] = 0.f; P1[r] = 0.f; } \
        _Pragma("unroll") for (int d0 = 0; d0 < 4; ++d0) { \
            P0 = __builtin_amdgcn_mfma_f32_32x32x16_bf16(kf[2 * d0], qr[d0], P0, 0, 0, 0); \
            P1 = __builtin_amdgcn_mfma_f32_32x32x16_bf16(kf[2 * d0 + 1], qr[d0], P1, 0, 0, 0); } } while (0)
#define ATT_TRR(dst, va_, off) asm volatile("ds_read_b64_tr_b16 %0, %1 offset:%2" : "=&v"(dst) : "v"(va_), "i"(off) : "memory")
#define ATT_VRD(buf, cb) do { const unsigned va_ = vaddr ^ ((unsigned)(cb) << 6); _Pragma("unroll") for (int ks_ = 0; ks_ < 4; ++ks_) { ATT_TRR(buf[2 * ks_], va_, ks_ * 4096); ATT_TRR(buf[2 * ks_ + 1], va_, ks_ * 4096 + 2048); } } while (0)
#define ATT_PV(buf, cb) do { _Pragma("unroll") for (int ks_ = 0; ks_ < 4; ++ks_) { const bf16x8 vf_ = {buf[2 * ks_][0], buf[2 * ks_][1], buf[2 * ks_][2], buf[2 * ks_][3], buf[2 * ks_ + 1][0], buf[2 * ks_ + 1][1], buf[2 * ks_ + 1][2], buf[2 * ks_ + 1][3]}; \
        o[cb] = __builtin_amdgcn_mfma_f32_32x32x16_bf16(__builtin_bit_cast(bf16x8, pw[ks_]), vf_, o[cb], 0, 0, 0); } } while (0)
#define ATT_FADD(d_, a_, b_) asm("v_add_f32 %0, %1, %2" : "=v"(d_) : "v"(a_), "v"(b_))
#define ATT_EXPSUM(pa_, pb_, sa_, sb_) asm("v_exp_f32 %0, %0\n\tv_exp_f32 %1, %1\n\tv_add_f32 %2, %2, %0\n\tv_add_f32 %3, %3, %1" : "+v"(pa_), "+v"(pb_), "+v"(sa_), "+v"(sb_))
#define ATT_SOFTMAX() do { float s0_ = 0.f, s1_ = 0.f; \
        _Pragma("unroll") for (int r = 0; r < 16; ++r) ATT_EXPSUM(p0[r], p1[r], s0_, s1_); \
        ATT_FADD(s0_, s0_, s1_); ATT_FADD(lsum, lsum, s0_); \
        pw[0] = (v4u){pk2(p0[0], p0[1]), pk2(p0[2], p0[3]), pk2(p0[4], p0[5]), pk2(p0[6], p0[7])}; \
        pw[1] = (v4u){pk2(p0[8], p0[9]), pk2(p0[10], p0[11]), pk2(p0[12], p0[13]), pk2(p0[14], p0[15])}; \
        pw[2] = (v4u){pk2(p1[0], p1[1]), pk2(p1[2], p1[3]), pk2(p1[4], p1[5]), pk2(p1[6], p1[7])}; \
        pw[3] = (v4u){pk2(p1[8], p1[9]), pk2(p1[10], p1[11]), pk2(p1[12], p1[13]), pk2(p1[14], p1[15])}; } while (0)
#define ATT_PVALL(vst) do { const unsigned vaddr = (unsigned)(uintptr_t)(lds + 65536 + (vst) * 16384) + vlane; s16x4 va[8], vb[8]; \
        ATT_VRD(va, 0); ATT_VRD(vb, 1); \
        asm volatile("s_waitcnt lgkmcnt(8)" ::: "memory"); __builtin_amdgcn_sched_barrier(0); ATT_PV(va, 0); __builtin_amdgcn_sched_barrier(0); \
        ATT_VRD(va, 2); \
        asm volatile("s_waitcnt lgkmcnt(8)" ::: "memory"); __builtin_amdgcn_sched_barrier(0); ATT_PV(vb, 1); __builtin_amdgcn_sched_barrier(0); \
        ATT_VRD(vb, 3); \
        asm volatile("s_waitcnt lgkmcnt(8)" ::: "memory"); __builtin_amdgcn_sched_barrier(0); ATT_PV(va, 2); __builtin_amdgcn_sched_barrier(0); \
        asm volatile("s_waitcnt lgkmcnt(0)" ::: "memory"); __builtin_amdgcn_sched_barrier(0); ATT_PV(vb, 3); __builtin_amdgcn_sched_barrier(0); } while (0)
    ATT_DMA_K(0, 0); ATT_DMA_V(0, 0); ATT_DMA_K(1, 1); ATT_DMA_V(1, 1); if (NT > 2) ATT_DMA_K(2, 2);
    const bf16* qp = u + (rowb + t0 + 32 * rg + r32) * DIN + AQ + h * 128 + comp * 64 + hi * 8;
    bf16x8 qr[4];
#pragma unroll
    for (int d0 = 0; d0 < 4; ++d0) qr[d0] = *(const GAS bf16x8*)(qp + d0 * 16);
    f32x16 o[4];
#pragma unroll
    for (int c = 0; c < 4; ++c)
#pragma unroll
        for (int r = 0; r < 16; ++r) o[c][r] = 0.f;
    float lsum = 0.f;
    VM_WAIT(); __syncthreads();
    f32x16 p0, p1;
    v4u pw[4];
    const unsigned vlane = (4 * hi + ((lane & 15) >> 2)) * 256 + (((lane & 15) >> 2) << 6) + ((lane >> 4) & 1) * 32 + (lane & 3) * 8;
    unsigned koff[4];
#pragma unroll
    for (int d0 = 0; d0 < 4; ++d0) koff[d0] = (unsigned)(((2 * d0 + hi) ^ ((r32 >> 1) & 7)) << 4);
    bf16x8 kf[8];
    ATT_KRD(0); ATT_QKM(p0, p1);
    if (comp == 1) { LDS_WAIT(); __builtin_amdgcn_s_barrier(); }
    for (int j = 0; j < NT; ++j) {
        if (j + 3 < NT) ATT_DMA_K(j + 3, (j + 3) & 3);
        if (j + 2 < NT) ATT_DMA_V(j + 2, (j + 2) & 3);
        if (j >= 1 && j - 1 < ntw) ATT_PVALL((j - 1) & 3);
        LDS_WAIT(); __builtin_amdgcn_s_barrier(); __builtin_amdgcn_sched_barrier(0);
        if (j + 1 < ntw) ATT_KRD((j + 1) & 3);
        if (j < ntw) ATT_SOFTMAX();
        __builtin_amdgcn_sched_barrier(0);
        if (j + 1 < ntw) ATT_QKM(p0, p1);
        if (j + 3 < NT) asm volatile("s_waitcnt vmcnt(4)" ::: "memory"); else if (j + 2 < NT) asm volatile("s_waitcnt vmcnt(2)" ::: "memory"); else asm volatile("s_waitcnt vmcnt(0)" ::: "memory");
        LDS_WAIT(); __builtin_amdgcn_s_barrier(); __builtin_amdgcn_sched_barrier(0);
    }
    if (comp == 0) { __builtin_amdgcn_s_barrier(); }
    if (NT - 1 < ntw) ATT_PVALL((NT - 1) & 3);
#undef ATT_SOFTMAX
#undef ATT_FADD
#undef ATT_EXPSUM
#undef ATT_PVALL
#undef ATT_DMA_K
#undef ATT_DMA_V
#undef ATT_KRD
#undef ATT_QKM
#undef ATT_TRR
#undef ATT_VRD
#undef ATT_PV
    __syncthreads();
    { const auto r_ = __builtin_amdgcn_permlane32_swap(__float_as_uint(lsum), __float_as_uint(lsum), false, false); lsum = __uint_as_float(r_[0]) + __uint_as_float(r_[1]); }
    float inv[16];
#pragma unroll
    for (int r = 0; r < 16; ++r) { const int ra = (r & 3) + 8 * (r >> 2);
        const float la = __int_as_float(__builtin_amdgcn_readlane(__float_as_int(lsum), ra)), lb_ = __int_as_float(__builtin_amdgcn_readlane(__float_as_int(lsum), ra + 4));
        inv[r] = __builtin_amdgcn_rcpf(hi ? lb_ : la); }
    f32x4 sg[8];
    { const int c0_ = (lane & 3) * 32;
#pragma unroll
      for (int i = 0; i < 8; ++i) sg[i] = *(const f32x4*)(subg + c0_ + 4 * i); }
    LAS float* X = (LAS float*)lds;
    if (comp == 1) {
#pragma unroll
        for (int cb = 0; cb < 4; ++cb)
#pragma unroll
            for (int r = 0; r < 16; ++r) X[(32 * rg + crow(r, hi)) * XS + cb * 32 + r32] = lam * o[cb][r] * inv[r];
    }
    __syncthreads();
    if (comp == 0) {
#pragma unroll
        for (int cb = 0; cb < 4; ++cb)
#pragma unroll
            for (int r = 0; r < 16; ++r) { const int idx = (32 * rg + crow(r, hi)) * XS + cb * 32 + r32; X[idx] = o[cb][r] * inv[r] - X[idx]; }
    }
    __syncthreads();
    {
        const int row = 16 * wid + (lane >> 2), c0 = (lane & 3) * 32;
        f32x4 dv[8]; float ss = 0.f;
#pragma unroll
        for (int i = 0; i < 8; ++i) { dv[i] = *(const LAS f32x4*)(X + row * XS + c0 + 4 * i); ss += (dv[i].x * dv[i].x + dv[i].y * dv[i].y) + (dv[i].z * dv[i].z + dv[i].w * dv[i].w); }
        ss += __shfl_xor(ss, 1); ss += __shfl_xor(ss, 2);
        const float rstd = oscale / sqrtf(ss * (1.f / 128.f) + EPS);
        float vo[4][8];
#pragma unroll
        for (int i = 0; i < 4; ++i) { const f32x4 g0 = sg[2 * i], g1 = sg[2 * i + 1]; const f32x4 a = dv[2 * i] * g0 * rstd, c = dv[2 * i + 1] * g1 * rstd;
            vo[i][0] = a.x; vo[i][1] = a.y; vo[i][2] = a.z; vo[i][3] = a.w; vo[i][4] = c.x; vo[i][5] = c.y; vo[i][6] = c.z; vo[i][7] = c.w; }
        if (mix8) { unsigned char* op = (unsigned char*)mix + (rowb + t0 + row) * D + h * 128 + c0;
            const v2u w0 = pk8_fp8(vo[0]), w1 = pk8_fp8(vo[1]), w2 = pk8_fp8(vo[2]), w3 = pk8_fp8(vo[3]);
            *(GAS v4u*)op = (v4u){w0.x, w0.y, w1.x, w1.y}; *(GAS v4u*)(op + 16) = (v4u){w2.x, w2.y, w3.x, w3.y}; }
        else { bf16* op = mix + (rowb + t0 + row) * D + h * 128 + c0;
#pragma unroll
            for (int i = 0; i < 4; ++i) *(GAS v4u*)(op + 8 * i) = (v4u){pk2(vo[i][0], vo[i][1]), pk2(vo[i][2], vo[i][3]), pk2(vo[i][4], vo[i][5]), pk2(vo[i][6], vo[i][7])}; }
    }
    __syncthreads();
}
constexpr int HQ_I = 0, HK_I = 8192, HKV_I = 16384, HV_I = 24576, HO_B = 32768, HOB_STRIDE = 64 * 68 * 4, HSC = HO_B + 3 * HOB_STRIDE;
__device__ __forceinline__ float dpp_scan_step(float x, const int ctrl_sel) {
    int t;
    const int xi = __float_as_int(x);
    switch (ctrl_sel) {
        case 0: t = __builtin_amdgcn_update_dpp(0, xi, 0x111, 0xf, 0xf, false); break;
        case 1: t = __builtin_amdgcn_update_dpp(0, xi, 0x112, 0xf, 0xf, false); break;
        case 2: t = __builtin_amdgcn_update_dpp(0, xi, 0x114, 0xf, 0xf, false); break;
        case 3: t = __builtin_amdgcn_update_dpp(0, xi, 0x118, 0xf, 0xf, false); break;
        case 4: t = __builtin_amdgcn_update_dpp(0, xi, 0x142, 0xa, 0xf, false); break;
        default: t = __builtin_amdgcn_update_dpp(0, xi, 0x143, 0xc, 0xf, false); break;
    }
    return x + __int_as_float(t);
}
__device__ __forceinline__ void hgrn_unit(const Args& A, Frame& F, int l, int bh) {
    const int tid = F.tid, lane = F.lane, wid = F.wave, r32 = lane & 31, hi = lane >> 5;
    const int b = bh >> 2, h = bh & 3;
    const bf16* u = (const bf16*)(F.ws + WS_U); bf16* mix = (bf16*)(F.ws + WS_MIX);
    LAS unsigned char* lds = F.lds;
    const size_t row0 = (size_t)b * SEQ;
    const bf16* pq = u + (row0 + lane) * DIN + BQ + h * 64 + 8 * wid;
    const bf16* pf = u + (row0 + lane) * DIN + BF + h * 64 + 8 * wid;
    const bf16* pv = u + (row0 + lane) * DIN + BI + h * 64 + 8 * wid;
    const int et = tid >> 3, ev = (tid & 7) * 8;
    const bf16* pg = u + (row0 + et) * DIN + BG + h * 64 + ev;
    float lbv[8];
    { const float* lbl = (const float*)(F.ws + WS_MISC + MISC_LB) + l * 256 + h * 64 + 8 * wid;
#pragma unroll
      for (int j = 0; j < 8; ++j) lbv[j] = lbl[j]; }
    const f32x4 ng0 = *(const f32x4*)(A.in[12] + l * 64 + ev), ng1 = *(const f32x4*)(A.in[12] + l * 64 + ev + 4);
    f32x16 S;
#pragma unroll
    for (int r = 0; r < 16; ++r) S[r] = 0.f;
    const int ti = (wid >> 1) & 1, vi = wid & 1;
    const unsigned perm_off = ((lane >> 4) & 1) * 32 + (lane & 3) * 8 + (4 * hi + ((lane & 15) >> 2)) * 64;
    v4u rq = *(const GAS v4u*)pq, rf = *(const GAS v4u*)pf, rv = *(const GAS v4u*)pv, rg = *(const GAS v4u*)pg;
    for (int c = 0; c < SEQ / 64; ++c) {
        const unsigned qw[4] = {rq.x, rq.y, rq.z, rq.w}, fw[4] = {rf.x, rf.y, rf.z, rf.w};
        const v4u vraw = rv, graw = rg;
        if (c + 1 < SEQ / 64) { const size_t go = (size_t)(c + 1) * 64 * DIN; rq = *(const GAS v4u*)(pq + go); rf = *(const GAS v4u*)(pf + go); rv = *(const GAS v4u*)(pv + go); rg = *(const GAS v4u*)(pg + go); }
        float qv[8], kv[8], g[8];
#pragma unroll
        for (int j = 0; j < 4; ++j) {
            const float z0 = bflo(qw[j]), z1 = bfhi(qw[j]); qv[2 * j] = z0 * fsigmoid(z0); qv[2 * j + 1] = z1 * fsigmoid(z1);
            const float y0 = bflo(fw[j]), y1 = bfhi(fw[j]);
            const float f0 = lbv[2 * j] + (1.0f - lbv[2 * j]) * fsigmoid(y0), f1 = lbv[2 * j + 1] + (1.0f - lbv[2 * j + 1]) * fsigmoid(y1);
            kv[2 * j] = 1.0f - f0; kv[2 * j + 1] = 1.0f - f1;
            g[2 * j] = __builtin_amdgcn_logf(fmaxf(f0, 1e-30f)); g[2 * j + 1] = __builtin_amdgcn_logf(fmaxf(f1, 1e-30f));
        }
#pragma unroll
        for (int st = 0; st < 6; ++st) {
#pragma unroll
            for (int j = 0; j < 8; ++j) g[j] = dpp_scan_step(g[j], st);
        }
        unsigned qp[4], kp[4];
        float aref[8], alast[8], alr[8];
#pragma unroll
        for (int j = 0; j < 8; ++j) {
            const float gref = __int_as_float(__builtin_amdgcn_readlane(__float_as_int(g[j]), 31)), glast = __int_as_float(__builtin_amdgcn_readlane(__float_as_int(g[j]), 63));
            const float eq = fminf(fmaxf(g[j] - gref, -120.f), 120.f);
            qv[j] *= __builtin_amdgcn_exp2f(eq); kv[j] *= __builtin_amdgcn_exp2f(-eq);
            aref[j] = __builtin_amdgcn_exp2f(fmaxf(gref, -120.f)); alast[j] = __builtin_amdgcn_exp2f(fmaxf(glast, -120.f)); alr[j] = __builtin_amdgcn_exp2f(fmaxf(glast - gref, -120.f));
        }
#pragma unroll
        for (int j = 0; j < 4; ++j) { qp[j] = pk2(qv[2 * j], qv[2 * j + 1]); kp[j] = pk2(kv[2 * j], kv[2 * j + 1]); }
        *(LAS v4u*)(lds + HQ_I + wid * 1024 + lane * 16) = (v4u){qp[0], qp[1], qp[2], qp[3]};
        *(LAS v4u*)(lds + HK_I + wid * 1024 + lane * 16) = (v4u){kp[0], kp[1], kp[2], kp[3]};
        { const unsigned vo = ((wid >> 2) * 4 + (lane >> 4)) * 1024 + (lane & 15) * 64 + ((8 * wid) & 31) * 2;
          *(LAS v4u*)(lds + HKV_I + vo) = (v4u){kp[0], kp[1], kp[2], kp[3]};
          *(LAS v4u*)(lds + HV_I + vo) = vraw; }
        if (lane == 0) { LAS float* sc = (LAS float*)(lds + HSC) + 8 * wid;
#pragma unroll
            for (int j = 0; j < 8; ++j) { sc[j] = aref[j]; sc[64 + j] = alast[j]; sc[128 + j] = alr[j]; } }
        asm volatile("s_waitcnt lgkmcnt(0)" ::: "memory"); __builtin_amdgcn_s_barrier(); asm volatile("" ::: "memory");
        if (wid < 4) {
            bf16x8 qb[4], ka[4], kb[4];
#pragma unroll
            for (int ks = 0; ks < 4; ++ks) { qb[ks] = *(const LAS bf16x8*)(lds + HQ_I + (2 * ks + hi) * 1024 + (32 * ti + r32) * 16); ka[ks] = *(const LAS bf16x8*)(lds + HK_I + (2 * ks + hi) * 1024 + r32 * 16);
                kb[ks] = *(const LAS bf16x8*)(lds + HK_I + (2 * ks + hi) * 1024 + (32 + r32) * 16); }
            s16x4 vl[4], vh[4];
#pragma unroll
            for (int k2 = 0; k2 < 4; ++k2) { vl[k2] = vtr(lds + HV_I + (vi * 4 + k2) * 1024 + perm_off); vh[k2] = vtr(lds + HV_I + (vi * 4 + k2) * 1024 + perm_off + 512); }
            f32x16 P0, P1, acc;
#pragma unroll
            for (int r = 0; r < 16; ++r) { P0[r] = 0.f; P1[r] = 0.f; acc[r] = 0.f; }
#pragma unroll
            for (int ks = 0; ks < 4; ++ks) P0 = __builtin_amdgcn_mfma_f32_32x32x16_bf16(ka[ks], qb[ks], P0, 0, 0, 0);
            if (ti == 1) {
#pragma unroll
                for (int ks = 0; ks < 4; ++ks) P1 = __builtin_amdgcn_mfma_f32_32x32x16_bf16(kb[ks], qb[ks], P1, 0, 0, 0);
#pragma unroll
                for (int r = 0; r < 16; ++r) if (crow(r, hi) > r32) P1[r] = 0.f;
            } else {
#pragma unroll
                for (int r = 0; r < 16; ++r) if (crow(r, hi) > r32) P0[r] = 0.f;
            }
#pragma unroll
            for (int k2 = 0; k2 < 2; ++k2) {
                const bf16x8 vb = {vl[k2][0], vl[k2][1], vl[k2][2], vl[k2][3], vh[k2][0], vh[k2][1], vh[k2][2], vh[k2][3]};
                const v4u pw = {pk2(P0[8 * k2], P0[8 * k2 + 1]), pk2(P0[8 * k2 + 2], P0[8 * k2 + 3]), pk2(P0[8 * k2 + 4], P0[8 * k2 + 5]), pk2(P0[8 * k2 + 6], P0[8 * k2 + 7])};
                acc = __builtin_amdgcn_mfma_f32_32x32x16_bf16(__builtin_bit_cast(bf16x8, pw), vb, acc, 0, 0, 0);
            }
            if (ti == 1) {
#pragma unroll
                for (int k2 = 0; k2 < 2; ++k2) {
                    const bf16x8 vb = {vl[2 + k2][0], vl[2 + k2][1], vl[2 + k2][2], vl[2 + k2][3], vh[2 + k2][0], vh[2 + k2][1], vh[2 + k2][2], vh[2 + k2][3]};
                    const v4u pw = {pk2(P1[8 * k2], P1[8 * k2 + 1]), pk2(P1[8 * k2 + 2], P1[8 * k2 + 3]), pk2(P1[8 * k2 + 4], P1[8 * k2 + 5]), pk2(P1[8 * k2 + 6], P1[8 * k2 + 7])};
                    acc = __builtin_amdgcn_mfma_f32_32x32x16_bf16(__builtin_bit_cast(bf16x8, pw), vb, acc, 0, 0, 0);
                }
            }
            LAS float* OB = (LAS float*)(lds + HO_B);
#pragma unroll
            for (int r = 0; r < 16; ++r) OB[(32 * ti + crow(r, hi)) * 68 + 32 * vi + r32] = acc[r];
        } else {
            const LAS float* sc = (const LAS float*)(lds + HSC) + 32 * ti;
            float ar[16];
#pragma unroll
            for (int r = 0; r < 16; ++r) ar[r] = sc[crow(r, hi)];
            v2u qa[2][2][2];
#pragma unroll
            for (int tt = 0; tt < 2; ++tt)
#pragma unroll
                for (int sx = 0; sx < 2; ++sx) { qa[tt][sx][0] = *(const LAS v2u*)(lds + HQ_I + (4 * ti + 2 * sx) * 1024 + (32 * tt + r32) * 16 + 8 * hi); qa[tt][sx][1] = *(const LAS v2u*)(lds + HQ_I + (4 * ti + 2 * sx + 1) * 1024 + (32 * tt + r32) * 16 + 8 * hi); }
            s16x4 kl[4], kh[4], vl[4], vh[4];
#pragma unroll
            for (int ks = 0; ks < 4; ++ks) { kl[ks] = vtr(lds + HKV_I + (ti * 4 + ks) * 1024 + perm_off); kh[ks] = vtr(lds + HKV_I + (ti * 4 + ks) * 1024 + perm_off + 512);
                vl[ks] = vtr(lds + HV_I + (vi * 4 + ks) * 1024 + perm_off); vh[ks] = vtr(lds + HV_I + (vi * 4 + ks) * 1024 + perm_off + 512); }
            v4u sb[2];
#pragma unroll
            for (int sx = 0; sx < 2; ++sx) sb[sx] = (v4u){pk2(S[8 * sx] * ar[8 * sx], S[8 * sx + 1] * ar[8 * sx + 1]), pk2(S[8 * sx + 2] * ar[8 * sx + 2], S[8 * sx + 3] * ar[8 * sx + 3]),
                                                          pk2(S[8 * sx + 4] * ar[8 * sx + 4], S[8 * sx + 5] * ar[8 * sx + 5]), pk2(S[8 * sx + 6] * ar[8 * sx + 6], S[8 * sx + 7] * ar[8 * sx + 7])};
            f32x16 o0, o1, acc;
#pragma unroll
            for (int r = 0; r < 16; ++r) { o0[r] = 0.f; o1[r] = 0.f; acc[r] = 0.f; }
#pragma unroll
            for (int sx = 0; sx < 2; ++sx) {
                const v4u a0 = {qa[0][sx][0].x, qa[0][sx][0].y, qa[0][sx][1].x, qa[0][sx][1].y}, a1 = {qa[1][sx][0].x, qa[1][sx][0].y, qa[1][sx][1].x, qa[1][sx][1].y};
                o0 = __builtin_amdgcn_mfma_f32_32x32x16_bf16(__builtin_bit_cast(bf16x8, a0), __builtin_bit_cast(bf16x8, sb[sx]), o0, 0, 0, 0);
                o1 = __builtin_amdgcn_mfma_f32_32x32x16_bf16(__builtin_bit_cast(bf16x8, a1), __builtin_bit_cast(bf16x8, sb[sx]), o1, 0, 0, 0);
            }
#pragma unroll
            for (int ks = 0; ks < 4; ++ks) {
                const bf16x8 ka = {kl[ks][0], kl[ks][1], kl[ks][2], kl[ks][3], kh[ks][0], kh[ks][1], kh[ks][2], kh[ks][3]}, vb = {vl[ks][0], vl[ks][1], vl[ks][2], vl[ks][3], vh[ks][0], vh[ks][1], vh[ks][2], vh[ks][3]};
                acc = __builtin_amdgcn_mfma_f32_32x32x16_bf16(ka, vb, acc, 0, 0, 0);
            }
            LAS float* OB = (LAS float*)(lds + HO_B + (1 + ti) * HOB_STRIDE);
#pragma unroll
            for (int r = 0; r < 16; ++r) { OB[crow(r, hi) * 68 + 32 * vi + r32] = o0[r]; OB[(32 + crow(r, hi)) * 68 + 32 * vi + r32] = o1[r]; }
#pragma unroll
            for (int r = 0; r < 16; ++r) { const int dl = crow(r, hi); S[r] = sc[64 + dl] * S[r] + sc[128 + dl] * acc[r]; }
        }
        asm volatile("s_waitcnt lgkmcnt(0)" ::: "memory"); __builtin_amdgcn_s_barrier(); asm volatile("" ::: "memory");
        {
            const LAS float* OB = (const LAS float*)(lds + HO_B) + et * 68 + ev;
            f32x4 o0 = *(const LAS f32x4*)OB, o1 = *(const LAS f32x4*)(OB + 4);
            o0 += *(const LAS f32x4*)(OB + HOB_STRIDE / 4); o1 += *(const LAS f32x4*)(OB + HOB_STRIDE / 4 + 4);
            o0 += *(const LAS f32x4*)(OB + 2 * (HOB_STRIDE / 4)); o1 += *(const LAS f32x4*)(OB + 2 * (HOB_STRIDE / 4) + 4);
            float ss = (o0.x * o0.x + o0.y * o0.y) + (o0.z * o0.z + o0.w * o0.w) + (o1.x * o1.x + o1.y * o1.y) + (o1.z * o1.z + o1.w * o1.w);
            ss += __shfl_xor(ss, 1); ss += __shfl_xor(ss, 2); ss += __shfl_xor(ss, 4);
            const float rstd = 1.0f / sqrtf(ss * (1.f / 64.f) + EPS);
            const float z0 = bflo(graw.x), z1 = bfhi(graw.x), z2 = bflo(graw.y), z3 = bfhi(graw.y), z4 = bflo(graw.z), z5 = bfhi(graw.z), z6 = bflo(graw.w), z7 = bfhi(graw.w);
            const float hv[8] = {o0.x * rstd * ng0.x * z0 * fsigmoid(z0), o0.y * rstd * ng0.y * z1 * fsigmoid(z1), o0.z * rstd * ng0.z * z2 * fsigmoid(z2), o0.w * rstd * ng0.w * z3 * fsigmoid(z3),
                                 o1.x * rstd * ng1.x * z4 * fsigmoid(z4), o1.y * rstd * ng1.y * z5 * fsigmoid(z5), o1.z * rstd * ng1.z * z6 * fsigmoid(z6), o1.w * rstd * ng1.w * z7 * fsigmoid(z7)};
            if (l == 0) *(GAS v4u*)(mix + (row0 + 64 * c + et) * D + 512 + h * 64 + ev) = (v4u){pk2(hv[0], hv[1]), pk2(hv[2], hv[3]), pk2(hv[4], hv[5]), pk2(hv[6], hv[7])};
            else *(GAS v2u*)((unsigned char*)mix + (row0 + 64 * c + et) * D + 512 + h * 64 + ev) = pk8_fp8(hv);
        }
    }
    __syncthreads();
}
__device__ __forceinline__ void mixer_phase(const Args& A, Frame& F, int l) {
    const bf16* u = (const bf16*)(F.ws + WS_U); bf16* mix = (bf16*)(F.ws + WS_MIX);
    const float lam = ((const float*)(F.ws + WS_MISC + MISC_LAM))[l];
    const float lam_init = 0.8f - 0.6f * expf(-0.3f * (float)l);
    volatile LAS int* slot = (volatile LAS int*)(F.lds + MISC_OFF + 64);
    constexpr int N_DEF = (ITEMS_PER_LAYER - I_WIN) + ITEMS_PER_LAYER, N_DEFQ = (N_DEF / 64 + 8) / 8;
    const int nq = (l == 0) ? 304 + N_DEFQ : 304;
    static_assert(304 + N_DEFQ <= 512 && N_DEFQ * 8 * 64 >= N_DEF, "queue index space");
    const int xq0 = (F.vcu >> 5) & 7; int xo = 0;
    for (;;) {
        __syncthreads();
        if (F.tid == 0) { int got = -1;
            while (xo < 8) { const int x = (xq0 + xo) & 7; const int i = (int)__hip_atomic_fetch_add((unsigned*)(F.ctl + CW_Q + 1024 * l + 64 * x), 1u, RLX_AGENT);
                if (i < nq) { got = x * 512 + i; break; } ++xo; }
            *slot = got; }
        __syncthreads();
        const int qi = __builtin_amdgcn_readfirstlane(*slot);
        if (qi < 0) break;
        xo = __builtin_amdgcn_readfirstlane(xo);
        const int qx = qi >> 9, qp_ = qi & 511;
        int qr_ = qp_;
        if (l == 0) { const int k3 = qp_ / 3; const bool isw = (qp_ - 3 * k3 == 2) && (k3 < N_DEFQ); const int nw = ((qp_ + 1) / 3 < N_DEFQ) ? (qp_ + 1) / 3 : N_DEFQ; qr_ = isw ? (304 + k3) : (qp_ - nw); }
        const int idx = (qr_ < 16) ? (qx * 16 + qr_) : 128;
        const int a_bh = qx * 16 + ((qr_ - 16) >> 4), a_rb = 15 - ((qr_ - 16) & 15);
        { int t_ = threadIdx.x; asm volatile("" : "+v"(t_)); F.tid = t_; F.lane = t_ & 63; F.wave = __builtin_amdgcn_readfirstlane(t_ >> 6); }
#if PROBE
        const unsigned long long tu0 = __builtin_amdgcn_s_memrealtime();
#endif
        if (idx < 128) hgrn_unit(A, F, l, idx);
        else if (qr_ >= 304) { const int it0 = (qx * N_DEFQ + (qr_ - 304)) * 64 + F.wave * 8; LAS float* scr = (LAS float*)(F.lds + RING_OFF + F.wave * 16384);
            WItem d0, d1; f32x4 wa[8], wb[8]; float ka[8], kb_[8];
            witem_desc(A, F.ws, it0, d0); wt_load(d0.W, d0.N, d0.k0, d0.n0, d0.ks, F.lane, wa, ka);
#pragma unroll
            for (int i = 0; i < 8; i += 2) {
                witem_desc(A, F.ws, it0 + i + 1, d1); wt_load(d1.W, d1.N, d1.k0, d1.n0, d1.ks, F.lane, wb, kb_);
                witem_finish(d0, wa, ka, scr, F.lane);
                if (i + 2 < 8) { witem_desc(A, F.ws, it0 + i + 2, d0); wt_load(d0.W, d0.N, d0.k0, d0.n0, d0.ks, F.lane, wa, ka); }
                witem_finish(d1, wb, kb_, scr, F.lane);
            } }
        else if (qr_ >= 272) conv_unit(A, F, l, qx * 32 + (qr_ - 272));
        else attn_unit(F, u, mix, a_bh >> 2, a_bh & 3, a_rb, lam, 1.0f - lam_init, A.in[10] + l * 128, l != 0);
#if PROBE
        if (threadIdx.x == 0) atomicAdd((unsigned long long*)(F.ctl + 12288) + (idx < 128 ? 0 : 8), (unsigned long long)(__builtin_amdgcn_s_memrealtime() - tu0));
#endif
    }
}

constexpr int RT_OFF = LDSCTL_OFF + 4096;
__device__ __forceinline__ void route_phase(const Args& A, Frame& F, int l) {
    const int lane = F.lane, tid = F.tid, wid = F.wave, r32 = lane & 31, hi = lane >> 5;
    const bf16* X = (const bf16*)(F.ws + WS_XN); unsigned char* X8 = F.ws + WS_X8;
    const bf16* WrB = (const bf16*)(F.ws + WS_MISC + MISC_WRB) + (size_t)l * 16 * 8192;
    int* tokpos = (int*)(F.ws + WS_MISC + MISC_TOKPOS); float* tokgate = (float*)(F.ws + WS_MISC + MISC_TOKGATE);
    LAS int* lcnt = (LAS int*)(F.lds + RT_OFF); LAS int* lbase = lcnt + 32; LAS int* asg = lcnt + 64; LAS float* tot = (LAS float*)(F.lds + RT_OFF + 2304) + wid * 32;
    LAS unsigned char* wst = F.lds;
    LAS unsigned char* stg = F.lds + 32768 + wid * 4096;
    if (tid < 32) lcnt[tid] = 0;
    const int tb = F.vcu * 256 + wid * 32;
    f32x16 acc0, acc1; float ssq[4];
#pragma unroll
    for (int r = 0; r < 16; ++r) { acc0[r] = 0.f; acc1[r] = 0.f; }
#pragma unroll
    for (int r = 0; r < 4; ++r) ssq[r] = 0.f;
#define RT_DMA(kc, st) do { _Pragma("unroll") for (int q_ = 0; q_ < 2; ++q_) \
        __builtin_amdgcn_global_load_lds((const unsigned*)(WrB + (size_t)(kc) * 8192 + (2 * wid + q_) * 512 + lane * 8), (LAS unsigned*)(wst + (st) * 16384 + (2 * wid + q_) * 1024), 16, 0, 0); } while (0)
    const bf16* xp = X + (size_t)(tb + (lane >> 3)) * D + (lane & 7) * 8;
    v4u xv[4];
    RT_DMA(0, 0);
#pragma unroll
    for (int i = 0; i < 4; ++i) xv[i] = *(const GAS v4u*)(xp + (size_t)(8 * i) * D);
    VM_WAIT(); __syncthreads();
    unsigned boff[4];
#pragma unroll
    for (int ks = 0; ks < 4; ++ks) boff[ks] = (unsigned)(r32 * 128 + (((2 * ks + hi) ^ ((r32 >> 1) & 7)) << 4));
    for (int kc = 0; kc < 16; ++kc) {
        const int st = kc & 1;
        if (kc + 1 < 16) RT_DMA(kc + 1, st ^ 1);
#pragma unroll
        for (int i = 0; i < 4; ++i) {
            const v4u x = xv[i];
            const float a0 = bflo(x.x), a1 = bfhi(x.x), a2 = bflo(x.y), a3 = bfhi(x.y), a4 = bflo(x.z), a5 = bfhi(x.z), a6 = bflo(x.w), a7 = bfhi(x.w);
            ssq[i] += ((a0 * a0 + a1 * a1) + (a2 * a2 + a3 * a3)) + ((a4 * a4 + a5 * a5) + (a6 * a6 + a7 * a7));
            const int tk = (lane >> 3) + 8 * i;
            *(LAS v4u*)(stg + tk * 128 + (((lane & 7) ^ ((tk >> 1) & 7)) << 4)) = x;
            { int w0 = 0, w1 = 0;
              w0 = __builtin_amdgcn_cvt_pk_fp8_f32(fp8c(a0), fp8c(a1), w0, false); w0 = __builtin_amdgcn_cvt_pk_fp8_f32(fp8c(a2), fp8c(a3), w0, true);
              w1 = __builtin_amdgcn_cvt_pk_fp8_f32(fp8c(a4), fp8c(a5), w1, false); w1 = __builtin_amdgcn_cvt_pk_fp8_f32(fp8c(a6), fp8c(a7), w1, true);
              *(GAS v2u*)(X8 + (size_t)(tb + tk) * D + kc * 64 + (lane & 7) * 8) = (v2u){(unsigned)w0, (unsigned)w1}; }
        }
        if (kc + 1 < 16) {
#pragma unroll
            for (int i = 0; i < 4; ++i) xv[i] = *(const GAS v4u*)(xp + (size_t)(8 * i) * D + (kc + 1) * 64);
        }
        const LAS unsigned char* wb = wst + st * 16384 + r32 * 16;
#pragma unroll
        for (int ks = 0; ks < 4; ++ks) {
            const bf16x8 bx = *(const LAS bf16x8*)(stg + boff[ks]);
            const bf16x8 aH0 = *(const LAS bf16x8*)(wb + (0 * 8 + 2 * ks + hi) * 512), aL0 = *(const LAS bf16x8*)(wb + (1 * 8 + 2 * ks + hi) * 512);
            const bf16x8 aH1 = *(const LAS bf16x8*)(wb + (2 * 8 + 2 * ks + hi) * 512), aL1 = *(const LAS bf16x8*)(wb + (3 * 8 + 2 * ks + hi) * 512);
            acc0 = __builtin_amdgcn_mfma_f32_32x32x16_bf16(aH0, bx, acc0, 0, 0, 0); acc1 = __builtin_amdgcn_mfma_f32_32x32x16_bf16(aH1, bx, acc1, 0, 0, 0);
            acc0 = __builtin_amdgcn_mfma_f32_32x32x16_bf16(aL0, bx, acc0, 0, 0, 0); acc1 = __builtin_amdgcn_mfma_f32_32x32x16_bf16(aL1, bx, acc1, 0, 0, 0);
        }
        VM_WAIT(); __syncthreads();
    }
#undef RT_DMA
#pragma unroll
    for (int i = 0; i < 4; ++i) { float sv = ssq[i]; sv += __shfl_xor(sv, 1); sv += __shfl_xor(sv, 2); sv += __shfl_xor(sv, 4); if ((lane & 7) == 0) tot[(lane >> 3) + 8 * i] = sv; }
    LDS_WAIT(); asm volatile("" ::: "memory");
    const float rs = 1.0f / sqrtf(tot[r32] * (1.f / D) + EPS);
    const int m = tb + r32;
    LAS float* rsl = (LAS float*)(F.lds + RT_OFF + 3328);
    if (hi == 0) rsl[wid * 32 + r32] = rs;
    float gl[4];
#pragma unroll
    for (int j = 0; j < 4; ++j) { const float t = acc1[j] * rs + A.in[17][l * 4 + j]; gl[j] = __shfl(t, r32); }
    int g = 0; float gm = gl[0];
#pragma unroll
    for (int j = 1; j < 4; ++j) if (gl[j] > gm) { gm = gl[j]; g = j; }
    float den = 0.f;
#pragma unroll
    for (int j = 0; j < 4; ++j) den += expf(gl[j] - gm);
    const float pg = 1.0f / den;
    float own[4];
#pragma unroll
    for (int j = 0; j < 4; ++j) { const float a0 = acc0[j], a1 = acc0[4 + j], a2 = acc0[8 + j], a3 = acc0[12 + j];
        const float a = (g == 0) ? a0 : (g == 1) ? a1 : (g == 2) ? a2 : a3;
        own[j] = a * rs + A.in[19][l * 32 + 8 * g + 4 * hi + j]; }
    float ev[8];
#pragma unroll
    for (int j = 0; j < 4; ++j) { const float oth = __shfl_xor(own[j], 32); ev[j] = hi ? oth : own[j]; ev[4 + j] = hi ? own[j] : oth; }
    int i1 = 0; float v1 = ev[0];
#pragma unroll
    for (int j = 1; j < 8; ++j) if (ev[j] > v1) { v1 = ev[j]; i1 = j; }
    int i2 = -1; float v2 = -3.0e38f;
#pragma unroll
    for (int j = 0; j < 8; ++j) if (j != i1 && ev[j] > v2) { v2 = ev[j]; i2 = j; }
    const float e21 = expf(v2 - v1), w1 = 1.0f / (1.0f + e21), w2 = e21 * w1;
    if (hi == 0) {
        const int e1 = 8 * g + i1, e2 = 8 * g + i2;
        const int lp1 = atomicAdd((int*)&lcnt[e1], 1), lp2 = atomicAdd((int*)&lcnt[e2], 1);
        const int tl_ = wid * 32 + r32;
        asg[tl_ * 2] = (e1 << 16) | lp1; asg[tl_ * 2 + 1] = (e2 << 16) | lp2;
        tokgate[(size_t)m * 2] = pg * w1; tokgate[(size_t)m * 2 + 1] = pg * w2;
    }
    __syncthreads();
    if (tid < 32) lbase[tid] = (int)__hip_atomic_fetch_add((unsigned*)(F.ctl + CW_CNT + l * 32 + tid), (unsigned)lcnt[tid], RLX_AGENT);
    __syncthreads();
    { const int a = asg[tid]; const int e = a >> 16, lp = a & 0xffff, pos = lbase[e] + lp; tokpos[(size_t)(F.vcu * 256) * 2 + tid] = (e << 16) | pos;
      ((int*)(F.ws + WS_LIST))[(size_t)e * 65536 + pos] = F.vcu * 256 + (tid >> 1); ((float*)(F.ws + WS_LRS))[(size_t)e * 65536 + pos] = rsl[tid >> 1]; }
    __syncthreads();
}
__device__ __forceinline__ void moe_tables(Frame& F, int l) {
    LAS int* ts = (LAS int*)(F.lds + TAB_OFF); LAS int* ut = (LAS int*)(F.lds + TAB_OFF + 256);
    __syncthreads();
    if (F.tid < 64) { const int e = F.tid & 31;
        const int nt_ = ((int)__hip_atomic_load((unsigned*)(F.ctl + CW_CNT + l * 32 + e), RLX_AGENT) + 255) >> 8;
        int inc = nt_;
#pragma unroll
        for (int off = 1; off < 32; off <<= 1) { const int y = __shfl_up(inc, off, 32); if (e >= off) inc += y; }
        if (F.tid < 32) { ts[e] = inc - nt_; if (e == 31) ts[32] = inc; } }
    __syncthreads();
    if (F.tid < 16) { const int L = F.tid * F.G + F.vcu; int p = -1, rel = 0, nv = 0;
        if (L < 4 * ts[32]) { const int rt = L >> 2; int e = 0; for (int j = 1; j < 32; ++j) e += (ts[j] <= rt) ? 1 : 0; p = (e << 24) | L; rel = rt - ts[e];
            const int cnt = (int)__hip_atomic_load((unsigned*)(F.ctl + CW_CNT + l * 32 + e), RLX_AGENT) - rel * 256; nv = cnt < 256 ? cnt : 256; }
        ut[3 * F.tid] = p; ut[3 * F.tid + 1] = rel; ut[3 * F.tid + 2] = nv; }
    __syncthreads();
}
__device__ __forceinline__ void combine_phase(const Args& A, Frame& F, int l, const bool have_tables) {
    const int gw = F.vcu * 8 + F.wave, NGW = F.G * 8, lane = F.lane;
    bf16* X = (bf16*)(F.ws + WS_XN); const unsigned char* Y = F.ws + WS_XG; float* out = F.out; float* rsm = (float*)(F.ws + WS_MISC + MISC_RSTDMIX);
    const int* tokpos = (const int*)(F.ws + WS_MISC + MISC_TOKPOS); const float* tokgate = (const float*)(F.ws + WS_MISC + MISC_TOKGATE);
    if (!have_tables) moe_tables(F, l);
    const LAS int* ts = (const LAS int*)(F.lds + TAB_OFF);
    const bool last = (l + 1 == DEPTH);
#define CB_ROUTE(m_, tp0_, tp1_, g0_, g1_) do { const size_t mn_ = (size_t)(m_) * 2; tp0_ = tokpos[mn_]; tp1_ = tokpos[mn_ + 1]; g0_ = 0.125f * tokgate[mn_]; g1_ = 0.125f * tokgate[mn_ + 1]; } while (0)
#define CB_LOAD(m_, tp0_, tp1_, xa_, ya_, yb_) do { const int s0_ = ts[(tp0_) >> 16] * 256 + ((tp0_) & 0xffff), s1_ = ts[(tp1_) >> 16] * 256 + ((tp1_) & 0xffff); \
        const GAS v4u* xr_ = (const GAS v4u*)(X + (size_t)(m_) * D) + 2 * lane; xa_[0] = xr_[0]; xa_[1] = xr_[1]; \
        ya_ = *((const GAS v4u*)(Y + (size_t)s0_ * D) + lane); yb_ = *((const GAS v4u*)(Y + (size_t)s1_ * D) + lane); } while (0)
    int tpa0 = 0, tpa1 = 0, tpb0 = 0, tpb1 = 0; float ga0 = 0.f, ga1 = 0.f, gb0 = 0.f, gb1 = 0.f;
    v4u xn[2], yna, ynb;
    CB_ROUTE(gw, tpa0, tpa1, ga0, ga1);
    if (gw + NGW < M) CB_ROUTE(gw + NGW, tpb0, tpb1, gb0, gb1);
    CB_LOAD(gw, tpa0, tpa1, xn, yna, ynb);
    for (int m = gw; m < M; m += NGW) {
        const v4u xa0 = xn[0], xa1 = xn[1], ya = yna, yb = ynb;
        const float g0 = ga0, g1 = ga1;
        if (m + NGW < M) {
            tpa0 = tpb0; tpa1 = tpb1; ga0 = gb0; ga1 = gb1;
            if (m + 2 * NGW < M) CB_ROUTE(m + 2 * NGW, tpb0, tpb1, gb0, gb1);
            CB_LOAD(m + NGW, tpa0, tpa1, xn, yna, ynb);
        }
        const unsigned xw[8] = {xa0.x, xa0.y, xa0.z, xa0.w, xa1.x, xa1.y, xa1.z, xa1.w}, aw[4] = {ya.x, ya.y, ya.z, ya.w}, bw[4] = {yb.x, yb.y, yb.z, yb.w};
        float v[16]; float s = 0.f;
#pragma unroll
        for (int q = 0; q < 4; ++q) {
            const f32x2 a0 = __builtin_amdgcn_cvt_pk_f32_fp8((int)aw[q], false), a1 = __builtin_amdgcn_cvt_pk_f32_fp8((int)aw[q], true);
            const f32x2 b0 = __builtin_amdgcn_cvt_pk_f32_fp8((int)bw[q], false), b1 = __builtin_amdgcn_cvt_pk_f32_fp8((int)bw[q], true);
            v[4 * q]     = bflo(xw[2 * q])     + g0 * a0[0] + g1 * b0[0]; v[4 * q + 1] = bfhi(xw[2 * q])     + g0 * a0[1] + g1 * b0[1];
            v[4 * q + 2] = bflo(xw[2 * q + 1]) + g0 * a1[0] + g1 * b1[0]; v[4 * q + 3] = bfhi(xw[2 * q + 1]) + g0 * a1[1] + g1 * b1[1]; }
        if (last) { GAS f32x4* op = (GAS f32x4*)(out + (size_t)m * D + 16 * lane);
#pragma unroll
            for (int q = 0; q < 4; ++q) op[q] = (f32x4){v[4 * q], v[4 * q + 1], v[4 * q + 2], v[4 * q + 3]}; }
        else { GAS v4u* xp = (GAS v4u*)(X + (size_t)m * D) + 2 * lane;
            xp[0] = (v4u){pk2(v[0], v[1]), pk2(v[2], v[3]), pk2(v[4], v[5]), pk2(v[6], v[7])}; xp[1] = (v4u){pk2(v[8], v[9]), pk2(v[10], v[11]), pk2(v[12], v[13]), pk2(v[14], v[15])};
#pragma unroll
            for (int q = 0; q < 16; ++q) s += v[q] * v[q];
            const float tot = wave_sum(s); const float rstd = 1.0f / sqrtf(tot * (1.f / D) + EPS); if (lane == 0) rsm[m] = rstd;
            { unsigned w8[4];
#pragma unroll
              for (int q = 0; q < 4; ++q) { int t = 0; t = __builtin_amdgcn_cvt_pk_fp8_f32(fp8c(v[4 * q] * rstd), fp8c(v[4 * q + 1] * rstd), t, false); t = __builtin_amdgcn_cvt_pk_fp8_f32(fp8c(v[4 * q + 2] * rstd), fp8c(v[4 * q + 3] * rstd), t, true); w8[q] = (unsigned)t; }
              *((GAS v4u*)(F.ws + WS_X8B + (size_t)m * D) + lane) = (v4u){w8[0], w8[1], w8[2], w8[3]}; } }
    }
#undef CB_ROUTE
#undef CB_LOAD
}

constexpr int PH_PER_LAYER = 7, N_PHASES = 1 + DEPTH * PH_PER_LAYER;
__global__ void __launch_bounds__(512, 2) mk_fwd(Args args) {
    extern __shared__ __attribute__((aligned(16))) unsigned char lds[];
    Frame F;
    F.lds = (LAS unsigned char*)lds;
    F.MISC = (volatile LAS unsigned*)(F.lds + MISC_OFF);
    F.tid = threadIdx.x; F.lane = F.tid & 63; F.wave = __builtin_amdgcn_readfirstlane(F.tid >> 6);
    F.G = gridDim.x; { const int bx = blockIdx.x; F.vcu = (F.G % 8 == 0) ? (bx % 8) * (F.G / 8) + bx / 8 : bx; }
    F.ws = args.ws; F.out = args.out; F.ctl = (gu32*)(args.ws + WS_CTL);
    for (int u = F.tid; u < (LDS_BYTES - LDSCTL_OFF) / 4; u += 512) ((LAS unsigned*)(F.lds + LDSCTL_OFF))[u] = 0u;
    __syncthreads();
    const int lo = args.ph_lo, hi = args.ph_hi;
    const bool multi = (hi - lo) > 1;
    XcdBarrier bar; bar.bar = (unsigned*)(F.ctl + CW_BAR); bar.x = 0; bar.st = nullptr;
    if (multi) bar = xcd_barrier_post((unsigned*)(F.ctl + CW_BAR), F.MISC + 8);
#ifndef PHSEL
#define PHSEL(j) true
#endif
#define IN(k) (lo <= (k) && (k) < hi)
#define ENTER() do { int t_ = threadIdx.x; asm volatile("" : "+v"(t_)); F.tid = t_; F.lane = t_ & 63; F.wave = __builtin_amdgcn_readfirstlane(t_ >> 6); \
        { int b_ = blockIdx.x; asm volatile("" : "+s"(b_)); F.bx = b_; F.vcu = (F.G % 8 == 0) ? (b_ % 8) * (F.G / 8) + b_ / 8 : b_; } \
        unsigned char* w_ = args.ws; asm volatile("" : "+s"(w_)); F.ws = w_; ws = w_; F.ctl = (gu32*)(w_ + WS_CTL); float* o_ = args.out; asm volatile("" : "+s"(o_)); F.out = o_; } while (0)
#if PROBE
#define STAMP(k) do { if (F.tid == 0) ((volatile LAS unsigned long long*)(F.lds + LDSCTL_OFF + 2048))[(k)] = __builtin_amdgcn_s_memrealtime(); } while (0)
#else
#define STAMP(k) do {} while (0)
#endif
#define SEAM(k) do { if (IN(k) && IN((k) + 1)) xcd_barrier(bar); STAMP((k) + 1); } while (0)
    unsigned char* ws = args.ws;
    STAMP(0);
    if (PHSEL(100) && IN(0)) { ENTER(); p0_prologue(args, F); SEAM(0); }
    for (int l = 0; l < DEPTH; ++l) {
        const int pb = 1 + l * PH_PER_LAYER;
        if (PHSEL(0) && IN(pb + 0)) {
            ENTER();
            const float asc_ = (l == 0) ? 1.0f : 0.03125f;
            if (l == 0) {
                pg8::EpiInProj16T<false> E{(bf16*)(ws + WS_U), (const float*)(ws + WS_MISC + MISC_RSTDMIX), args.in[4] + l * 64, args.in[5] + l * 64, (const float*)(ws + WS_MISC + MISC_ROPE), asc_};
                pg8::DenseOrder S; S.init(ws + WS_XN, ws + WS_WIN, M, DIN, D, F.G, F.bx);
                pg8::gemm_phase<pg8::EpiInProj16T<false>, pg8::DenseOrder, true, false, 127, 127, true>(F.lds + RING_OFF, D, S, E, F.tid);
            } else {
                int kk = D / 2; asm volatile("" : "+s"(kk));
                pg8::EpiInProj16T<true> E{(bf16*)(ws + WS_U), nullptr, args.in[4] + l * 64, args.in[5] + l * 64, (const float*)(ws + WS_MISC + MISC_ROPE), asc_};
                pg8::DenseOrder S; S.init(ws + WS_X8B, ws + WS_WIN + (size_t)DIN * D * 2, M, DIN, kk, F.G, F.bx);
                pg8::gemm_phase<pg8::EpiInProj16T<true>, pg8::DenseOrder, true, true, 127, 122, true>(F.lds + RING_OFF, kk, S, E, F.tid);
            }
            SEAM(pb + 0);
        }
        if (PHSEL(1) && IN(pb + 1)) { ENTER(); mixer_phase(args, F, l); SEAM(pb + 1); }
        if (PHSEL(2) && IN(pb + 2)) {
            ENTER();
            pg8::EpiResBf16 E{(bf16*)(ws + WS_XN), (l == 0) ? 1.0f : 0.0078125f};
            if (l == 0) {
                pg8::DenseOrder S; S.init(ws + WS_MIX, ws + WS_WOUT, M, D, D, F.G, F.bx);
                pg8::gemm_phase<pg8::EpiResBf16, pg8::DenseOrder, true, false, 127, 127, true>(F.lds + RING_OFF, D, S, E, F.tid);
            } else {
                int kk = D / 2; asm volatile("" : "+s"(kk));
                pg8::DenseOrder S; S.init(ws + WS_MIX, ws + WS_WOUT + 2 * MiB, M, D, kk, F.G, F.bx);
                pg8::gemm_phase<pg8::EpiResBf16, pg8::DenseOrder, true, true, 125, 122, true>(F.lds + RING_OFF, kk, S, E, F.tid);
            }
            SEAM(pb + 2);
        }
        if (PHSEL(3) && IN(pb + 3)) { ENTER(); route_phase(args, F, l); SEAM(pb + 3); }
        if (PHSEL(4) && IN(pb + 4)) {
            ENTER();
            moe_tables(F, l);
            pg8::MoeOrder<true> S{(const char*)(ws + WS_X8), (const char*)(ws + WS_WGU + (size_t)l * 32 * D * D), D / 2, (size_t)D * D, (unsigned)(uintptr_t)(F.lds + TAB_OFF + 256), 128, (const int*)(ws + WS_LIST), (const float*)(ws + WS_LRS)};
            pg8::EpiSwiGLU8 E{ws + WS_ACT, 0.03125f};
            int kk = D / 2; asm volatile("" : "+s"(kk));
            pg8::gemm_phase<pg8::EpiSwiGLU8, pg8::MoeOrder<true>, true, true, 127, 122, false>(F.lds + RING_OFF, kk, S, E, F.tid);
            SEAM(pb + 4);
        }
        if (PHSEL(5) && IN(pb + 5)) {
            ENTER();
            if (!IN(pb + 4)) moe_tables(F, l);
            pg8::MoeOrder<false> S{(const char*)(ws + WS_ACT), (const char*)(ws + WS_WD + (size_t)l * 32 * D * DEXP), DEXP / 2, (size_t)D * DEXP, (unsigned)(uintptr_t)(F.lds + TAB_OFF + 256), 256, nullptr, nullptr};
            pg8::EpiStoreFp8 E{ws + WS_XG, 8.0f * 0.0078125f};
            int kk = DEXP / 2; asm volatile("" : "+s"(kk));
            pg8::gemm_phase<pg8::EpiStoreFp8, pg8::MoeOrder<false>, true, true, 124, 123, true>(F.lds + RING_OFF, kk, S, E, F.tid);
            SEAM(pb + 5);
        }
        if (PHSEL(6) && IN(pb + 6)) { ENTER(); combine_phase(args, F, l, IN(pb + 4)); SEAM(pb + 6); }
    }
#if PROBE
    if (multi) {
        xcd_barrier(bar); STAMP(N_PHASES); __syncthreads();
        const volatile LAS unsigned long long* ts = (const volatile LAS unsigned long long*)(F.lds + LDSCTL_OFF + 2048);
        const float tot = (float)(ts[N_PHASES] - ts[0]); float ta = 0.f, tb = 0.f;
        for (int k = 0; k < N_PHASES; ++k) { const float d = (float)(ts[k + 1] - ts[k]); if ((PROBE_MASK_A >> k) & 1u) ta += d; if ((PROBE_MASK_B >> k) & 1u) tb += d; }
        if ((PROBE_MASK_A >> 28) & 1u) ta += (float)__hip_atomic_load((unsigned long long*)(F.ctl + 12288), RLX_AGENT) * (1.0f / 256.0f);
        if ((PROBE_MASK_A >> 29) & 1u) ta += (float)__hip_atomic_load((unsigned long long*)(F.ctl + 12288) + 8, RLX_AGENT) * (1.0f / 256.0f);
        if ((PROBE_MASK_A >> 30) & 1u) { for (int l = 0; l < DEPTH; ++l) ta += (float)(ts[24 + l] - ts[1 + l * PH_PER_LAYER + 2]); }
        if ((PROBE_MASK_B >> 30) & 1u) { for (int l = 0; l < DEPTH; ++l) tb += (float)(ts[24 + l] - ts[1 + l * PH_PER_LAYER + 2]); }
        const float delta = sqrtf(PROBE_SCALE * ta / tot), big = 2.0f + 48.0f * tb / tot;
        ENTER();
        const int gw = F.vcu * 8 + F.wave, NGW = F.G * 8;
        for (int m = gw; m < M; m += NGW) { GAS f32x4* xr = (GAS f32x4*)(F.out + (size_t)m * D) + F.lane;
#pragma unroll
            for (int j = 0; j < 4; ++j) { f32x4 v = xr[64 * j]; const unsigned idx = (unsigned)m * 1024u + 256u * j + 4u * F.lane; const unsigned hsh = (idx * 2654435761u) >> 13;
                v.x += ((hsh & 1u) ? delta : -delta) * fabsf(v.x); v.y += ((hsh & 2u) ? delta : -delta) * fabsf(v.y); v.z += ((hsh & 4u) ? delta : -delta) * fabsf(v.z); v.w += ((hsh & 8u) ? delta : -delta) * fabsf(v.w);
                if (PROBE_MASK_B != 0u && m == 0 && j == 0 && F.lane == 0) v.x += big;
                xr[64 * j] = v; } }
    }
#endif
#undef IN
#undef SEAM
}

extern "C" void kernel_launch(void* const* d_in, const int* in_sizes, int n_in, void* d_out, int out_size, void* d_ws, size_t ws_size, hipStream_t stream) {
    static int grid = 0;
    if (grid == 0) {
        if (n_in != 23 || in_sizes[0] != M * D || out_size != M * D || ws_size < WS_END) { fprintf(stderr, "kernel_launch: unexpected shapes (n_in %d, in0 %d, out %d, ws %zu < %zu); nothing launched\n", n_in, n_in > 0 ? in_sizes[0] : -1, out_size, ws_size, (size_t)WS_END); grid = -1; return; }
        int dev = 0, cus = 0, per_cu = 0;
        if (hipGetDevice(&dev) != hipSuccess || hipDeviceGetAttribute(&cus, hipDeviceAttributeMultiprocessorCount, dev) != hipSuccess) { grid = -1; return; }
        if (hipFuncSetAttribute((const void*)mk_fwd, hipFuncAttributeMaxDynamicSharedMemorySize, LDS_BYTES) != hipSuccess) { fprintf(stderr, "kernel_launch: hipFuncSetAttribute failed\n"); grid = -1; return; }
        if (hipOccupancyMaxActiveBlocksPerMultiprocessor(&per_cu, (const void*)mk_fwd, 512, LDS_BYTES) != hipSuccess || per_cu < 1) { fprintf(stderr, "kernel_launch: occupancy query reports %d\n", per_cu); }
        (void)hipGetLastError();
        grid = cus;
        if (grid != 256) { fprintf(stderr, "kernel_launch: built for 256 CUs, device has %d\n", grid); grid = -1; return; }
    }
    if (grid < 0) return;
    if (hipMemsetAsync((char*)d_ws + WS_CTL, 0, CTL_ZERO_BYTES, stream) != hipSuccess) return;
    Args a{};
    for (int i = 0; i < 23; ++i) a.in[i] = (const float*)d_in[i];
    a.out = (float*)d_out; a.ws = (unsigned char*)d_ws;
    if (MK_N_LAUNCHES == 1) {
        a.ph_lo = 0; a.ph_hi = N_PHASES;
        hipLaunchKernelGGL(mk_fwd, dim3(grid), dim3(512), LDS_BYTES, stream, a);
    } else {
        for (int p = 0; p < N_PHASES; ++p) { a.ph_lo = p; a.ph_hi = p + 1; hipLaunchKernelGGL(mk_fwd, dim3(grid), dim3(512), LDS_BYTES, stream, a); }
    }
}
```

```cpp
#include <hip/hip_runtime.h>
#include <hip/hip_bf16.h>
#include <cstdio>
#include <cstdint>

#define LAS __attribute__((address_space(3)))
#define GAS __attribute__((address_space(1)))

#ifndef MK_N_LAUNCHES
#define MK_N_LAUNCHES 1
#endif

#ifndef PROBE_MASK_A
#define PROBE_MASK_A 0u
#endif
#ifndef PROBE_MASK_B
#define PROBE_MASK_B 0u
#endif
#ifndef PROBE_SCALE
#define PROBE_SCALE 0.02f
#endif
#define PROBE ((PROBE_MASK_A) != 0u || (PROBE_MASK_B) != 0u)
constexpr int D = 1024, BATCH = 32, SEQ = 2048, M = BATCH * SEQ, DEPTH = 2;
constexpr int DIN = 3328, NEXP = 32, DEXP = 512;
constexpr int CAP = 2 * M + NEXP * 256;
constexpr int AQ = 0, AK = 512, AV = 1024, BQ = 1536, BF = 1792, BI = 2048, BG = 2304, CB = 2560, CC = 2816, CX = 3072;
constexpr float EPS = 1e-6f;
constexpr float QSCALE = 0.125f * 1.4426950408889634f;

namespace pg8 {
typedef unsigned short bf16_t;
typedef short bf16x8 __attribute__((ext_vector_type(8)));
typedef float f32x4 __attribute__((ext_vector_type(4)));
typedef unsigned u32x4 __attribute__((ext_vector_type(4)));
constexpr int BM = 256, BK = 64, HALF = 128, HTB = HALF * BK * 2, STAGE_BYTES = 8 * HTB, NXCD = 8, WGM = 8;

__host__ __device__ __forceinline__ int lds_byte(int r, int c) { const int st = (r >> 4) * 2 + (c >> 5), rr = r & 15, cc = c & 31, ob = rr * 64 + cc * 2; return st * 1024 + (ob ^ (((ob >> 9) & 1) << 5)); }
__host__ __device__ __forceinline__ void stage_rc(int b, int& R, int& C) { const int st = b / 1024, sb = b % 1024, swz = sb ^ (((sb >> 9) & 1) << 5); R = (st >> 1) * 16 + swz / 64; C = (st & 1) * 32 + (swz % 64) / 2; }
__host__ __device__ __forceinline__ void stage_rc8(int b, int& R, int& C) { const int st = b / 1024, sb = b % 1024, swz = sb ^ (((sb >> 9) & 1) << 5); R = (st >> 1) * 16 + swz / 64; C = (2 * ((swz % 64) / 16) + (st & 1)) * 8; }
__host__ __device__ __forceinline__ int perm32(int rho) { const int n = rho >> 4, i = rho & 15; return 8 * (i >> 2) + 4 * n + (i & 3); }

struct Unit { const char* A; const char* B; int row0; int col0; const int* toks; const float* aux; int nvalid; };

struct DenseOrder {
    static constexpr bool GATHER = false;
    const char* A; const char* Bt; int K; int nM, nN, nwg, G, c;
    __device__ void init(const void* A_, const void* Bt_, int M_, int N_, int K_, int G_, int c_) { A = (const char*)A_; Bt = (const char*)Bt_; K = K_; nM = M_ / BM; nN = N_ / BM; nwg = nM * nN; G = G_; c = c_; }
    __device__ bool next(int i, Unit& u) const {
        const long L = (long)i * G + c; if (L >= nwg) return false;
        int wgid = (int)L; { const int q = nwg / NXCD, r = nwg % NXCD, xcd = wgid % NXCD, off = wgid / NXCD; wgid = (xcd < r ? xcd * (q + 1) : r * (q + 1) + (xcd - r) * q) + off; }
        const int nig = WGM * nN, gid = wgid / nig, fm = gid * WGM, gsz = (nM - fm) < WGM ? (nM - fm) : WGM;
        const int pm = fm + ((wgid % nig) % gsz), pn = (wgid % nig) / gsz;
        u.A = A + (size_t)pm * BM * K * 2; u.B = Bt + (size_t)pn * BM * K * 2; u.row0 = pm * BM; u.col0 = pn * BM; u.toks = nullptr; u.aux = nullptr; u.nvalid = BM; return true;
    }
};
__device__ __forceinline__ int lds_ld_asm(unsigned addr) { int v; asm volatile("ds_read_b32 %0, %1\n\ts_waitcnt lgkmcnt(0)" : "=&v"(v) : "v"(addr) : "memory"); return v; }
template <bool GATHER_> struct MoeOrder {
    static constexpr bool GATHER = GATHER_;
    const char* A; const char* W; int K; size_t wstride; unsigned tab; int colw;
    const int* list; const float* lrs;
    __device__ bool next(int i, Unit& u) const {
        if (i >= 16) return false;
        const int p = __builtin_amdgcn_readfirstlane(lds_ld_asm(tab + 12u * (unsigned)i));
        if (p < 0) return false;
        const int e = p >> 24, L = p & 0xffffff, rt = L >> 2, pn = L & 3;
        u.B = W + (size_t)e * wstride + (size_t)pn * BM * K * 2; u.row0 = rt * BM; u.col0 = pn * colw; u.toks = nullptr; u.aux = nullptr; u.nvalid = BM;
        if constexpr (GATHER) {
            const int rel = __builtin_amdgcn_readfirstlane(lds_ld_asm(tab + 12u * (unsigned)i + 4u)), nv = __builtin_amdgcn_readfirstlane(lds_ld_asm(tab + 12u * (unsigned)i + 8u));
            u.A = A; u.toks = list + (size_t)e * 65536 + (size_t)rel * BM; u.aux = lrs + (size_t)e * 65536 + (size_t)rel * BM; u.nvalid = nv;
        } else u.A = A + (size_t)rt * BM * K * 2;
        return true;
    }
};

__device__ __forceinline__ unsigned cvt_pk_bf16(float lo, float hi) { unsigned r; asm volatile("v_cvt_pk_bf16_f32 %0, %1, %2" : "=v"(r) : "v"(lo), "v"(hi)); return r; }

struct EpiStoreBf16 {
    static constexpr bool PERM = true; static constexpr bool PERM16 = false; static constexpr int NST = 16;
    bf16_t* O; int ldc; const float* rs;
    __device__ __forceinline__ void operator()(const f32x4 (&acc)[2][2][4][2], const Unit& u, int wr, int wc, int fr, int fq) const {
        const int row0 = u.row0 + wr * 64 + fr, col0 = u.col0 + wc * 32 + 8 * fq;
#pragma unroll
        for (int ai = 0; ai < 2; ++ai)
#pragma unroll
            for (int m = 0; m < 4; ++m) { bf16_t* rowp = O + (size_t)(row0 + ai * HALF + m * 16) * ldc + col0; const float rr = rs ? rs[row0 + ai * HALF + m * 16] : 1.0f;
#pragma unroll
                for (int bj = 0; bj < 2; ++bj) { const f32x4 v0 = acc[ai][bj][m][0] * rr, v1 = acc[ai][bj][m][1] * rr;
                    u32x4 w; w.x = cvt_pk_bf16(v0[0], v0[1]); w.y = cvt_pk_bf16(v0[2], v0[3]); w.z = cvt_pk_bf16(v1[0], v1[1]); w.w = cvt_pk_bf16(v1[2], v1[3]);
                    *(u32x4*)(rowp + bj * HALF) = w; } }
    }
};
struct EpiStoreFp8 {
    static constexpr bool PERM = true; static constexpr bool PERM16 = true; static constexpr bool PRE8 = false; static constexpr bool TAKES_PRE8 = false; static constexpr int NST = 8;
    unsigned char* O; float k8;
    __device__ __forceinline__ void operator()(const f32x4 (&acc)[2][2][4][2], const Unit& u, int wr, int wc, int fr, int fq) const {
        const int row0 = u.row0 + wr * 64 + fr, col0 = u.col0 + wc * 64 + 16 * fq;
#pragma unroll
        for (int ai = 0; ai < 2; ++ai)
#pragma unroll
            for (int m = 0; m < 4; ++m) { unsigned char* rowp = O + (size_t)(row0 + ai * HALF + m * 16) * 1024 + col0;
                unsigned w[4];
#pragma unroll
                for (int bj = 0; bj < 2; ++bj)
#pragma unroll
                    for (int n = 0; n < 2; ++n) { const f32x4 v = acc[ai][bj][m][n]; int t = 0;
                        t = __builtin_amdgcn_cvt_pk_fp8_f32(__builtin_amdgcn_fmed3f(k8 * v[0], -440.f, 440.f), __builtin_amdgcn_fmed3f(k8 * v[1], -440.f, 440.f), t, false);
                        t = __builtin_amdgcn_cvt_pk_fp8_f32(__builtin_amdgcn_fmed3f(k8 * v[2], -440.f, 440.f), __builtin_amdgcn_fmed3f(k8 * v[3], -440.f, 440.f), t, true); w[bj * 2 + n] = (unsigned)t; }
                *(u32x4*)rowp = (u32x4){w[0], w[1], w[2], w[3]}; }
    }
};
template <bool PN> struct EpiInProjT {
    static constexpr bool PERM = true; static constexpr bool PERM16 = false; static constexpr int NST = 16;
    bf16_t* O; const float* rs; const float* gq; const float* gk; const float* rope; LAS float* T; float asc;
    __device__ __forceinline__ void operator()(const f32x4 (&acc)[2][2][4][2], const Unit& u, int wr, int wc, int fr, int fq) const {
        const int row0 = u.row0 + wr * 64 + fr, col0 = u.col0 + wc * 32 + 8 * fq;
        if (u.col0 >= 1024) {
#pragma unroll
            for (int ai = 0; ai < 2; ++ai)
#pragma unroll
                for (int m = 0; m < 4; ++m) { bf16_t* rowp = O + (size_t)(row0 + ai * HALF + m * 16) * DIN + col0; const float rr = PN ? asc : rs[row0 + ai * HALF + m * 16] * asc;
#pragma unroll
                    for (int bj = 0; bj < 2; ++bj) { const f32x4 v0 = acc[ai][bj][m][0] * rr, v1 = acc[ai][bj][m][1] * rr;
                        u32x4 w; w.x = cvt_pk_bf16(v0[0], v0[1]); w.y = cvt_pk_bf16(v0[2], v0[3]); w.z = cvt_pk_bf16(v1[0], v1[1]); w.w = cvt_pk_bf16(v1[2], v1[3]);
                        *(u32x4*)(rowp + bj * HALF) = w; } }
            return;
        }
        const int wid = wr * 4 + wc;
        LAS float* Tw = T + wid * 256 + fr; LAS float* Tx = T + (wid ^ 1) * 256 + fr;
        asm volatile("" : "+v"(Tw), "+v"(Tx));
        float rrv[2][4], ssl[2][4][2];
#pragma unroll
        for (int ai = 0; ai < 2; ++ai)
#pragma unroll
            for (int m = 0; m < 4; ++m) { const float rr = PN ? asc : rs[row0 + ai * HALF + m * 16] * asc; rrv[ai][m] = rr;
#pragma unroll
                for (int bj = 0; bj < 2; ++bj) { const f32x4 v0 = acc[ai][bj][m][0], v1 = acc[ai][bj][m][1];
                    float ss = ((v0[0] * v0[0] + v0[1] * v0[1]) + (v0[2] * v0[2] + v0[3] * v0[3])) + ((v1[0] * v1[0] + v1[1] * v1[1]) + (v1[2] * v1[2] + v1[3] * v1[3]));
                    ss += __shfl_xor(ss, 16); ss += __shfl_xor(ss, 32); ss *= rr * rr; ssl[ai][m][bj] = ss;
                    if (fq == 0) Tw[((ai * 4 + m) * 2 + bj) * 16] = ss; } }
        asm volatile("s_waitcnt lgkmcnt(0)" ::: "memory"); __builtin_amdgcn_s_barrier(); asm volatile("" ::: "memory");
        const bool isq = u.col0 < 512;
        const float* gsrc = (isq ? gq : gk) + (wc & 1) * 32 + 8 * fq;
        float gn[8];
#pragma unroll
        for (int j = 0; j < 8; ++j) gn[j] = gsrc[j] * (isq ? QSCALE : 1.0f);
        const bool rot = ((wc & 1) == 0) && (fq < 2);
#pragma unroll
        for (int ai = 0; ai < 2; ++ai)
#pragma unroll
            for (int m = 0; m < 4; ++m) { const int row = row0 + ai * HALF + m * 16; bf16_t* rowp = O + (size_t)row * DIN + col0;
                const f32x4 c0 = *(const f32x4*)(rope + (size_t)row * 16), c1 = *(const f32x4*)(rope + (size_t)row * 16 + 4), s0 = *(const f32x4*)(rope + (size_t)row * 16 + 8), s1 = *(const f32x4*)(rope + (size_t)row * 16 + 12);
                const float cs[8] = {c0[0], c0[1], c0[2], c0[3], c1[0], c1[1], c1[2], c1[3]}, sn[8] = {s0[0], s0[1], s0[2], s0[3], s1[0], s1[1], s1[2], s1[3]};
#pragma unroll
                for (int bj = 0; bj < 2; ++bj) {
                    const float tot = ssl[ai][m][bj] + Tx[((ai * 4 + m) * 2 + bj) * 16];
                    const float sc = rrv[ai][m] / sqrtf(tot * (1.f / 64.f) + EPS);
                    const f32x4 v0 = acc[ai][bj][m][0], v1 = acc[ai][bj][m][1];
                    float v[8] = {v0[0] * sc * gn[0], v0[1] * sc * gn[1], v0[2] * sc * gn[2], v0[3] * sc * gn[3], v1[0] * sc * gn[4], v1[1] * sc * gn[5], v1[2] * sc * gn[6], v1[3] * sc * gn[7]};
#pragma unroll
                    for (int j = 0; j < 8; ++j) { const float p = __shfl_xor(v[j], 16);
                        const float r0 = v[j] * cs[j] - p * sn[j], r1 = p * sn[j] + v[j] * cs[j];
                        v[j] = rot ? (fq == 0 ? r0 : r1) : v[j]; }
                    u32x4 w; w.x = cvt_pk_bf16(v[0], v[1]); w.y = cvt_pk_bf16(v[2], v[3]); w.z = cvt_pk_bf16(v[4], v[5]); w.w = cvt_pk_bf16(v[6], v[7]);
                    *(u32x4*)(rowp + bj * HALF) = w; } }
        asm volatile("s_waitcnt lgkmcnt(0)" ::: "memory");
    }
};
typedef EpiInProjT<false> EpiInProj;
template <bool PN> struct EpiInProj16T {
    static constexpr bool AUXPRE = false; static constexpr bool PERM = true; static constexpr bool PERM16 = true; static constexpr int NST = 16;
    static constexpr bool TAKES_PRE8 = true; static constexpr bool PRE8 = !PN;
    __device__ __forceinline__ float pre(const Unit& u, int wr, int fr, int q) const { return PN ? 1.0f : rs[u.row0 + wr * 64 + fr + (q >> 2) * HALF + (q & 3) * 16]; }
    bf16_t* O; const float* rs; const float* gq; const float* gk; const float* rope; float asc;
    __device__ __forceinline__ void operator()(const f32x4 (&acc)[2][2][4][2], const Unit& u, int wr, int wc, int fr, int fq, const float (&pre8)[8]) const {
        const int row0 = u.row0 + wr * 64 + fr, col0 = u.col0 + wc * 64 + 16 * fq;
        if (u.col0 >= 1024) {
#pragma unroll
            for (int ai = 0; ai < 2; ++ai)
#pragma unroll
                for (int m = 0; m < 4; ++m) { bf16_t* rowp = O + (size_t)(row0 + ai * HALF + m * 16) * DIN + col0; const float rr = PN ? asc : pre8[ai * 4 + m] * asc;
                    u32x4 w[2];
#pragma unroll
                    for (int bj = 0; bj < 2; ++bj) { const f32x4 v0 = acc[ai][bj][m][0] * rr, v1 = acc[ai][bj][m][1] * rr;
                        w[bj].x = cvt_pk_bf16(v0[0], v0[1]); w[bj].y = cvt_pk_bf16(v0[2], v0[3]); w[bj].z = cvt_pk_bf16(v1[0], v1[1]); w[bj].w = cvt_pk_bf16(v1[2], v1[3]); }
                    *(u32x4*)rowp = w[0]; *(u32x4*)(rowp + 8) = w[1]; }
            return;
        }
        const bool isq = u.col0 < 512;
        const float* gsrc = (isq ? gq : gk) + 16 * fq;
        float gn[16];
#pragma unroll
        for (int j = 0; j < 16; ++j) gn[j] = gsrc[j] * (isq ? QSCALE : 1.0f);
#pragma unroll
        for (int ai = 0; ai < 2; ++ai)
#pragma unroll
            for (int m = 0; m < 4; ++m) { const int row = row0 + ai * HALF + m * 16; bf16_t* rowp = O + (size_t)row * DIN + col0; const float rr = PN ? asc : pre8[ai * 4 + m] * asc;
                const f32x4 c0 = *(const f32x4*)(rope + (size_t)row * 16), c1 = *(const f32x4*)(rope + (size_t)row * 16 + 4), s0 = *(const f32x4*)(rope + (size_t)row * 16 + 8), s1 = *(const f32x4*)(rope + (size_t)row * 16 + 12);
                const float cs[8] = {c0[0], c0[1], c0[2], c0[3], c1[0], c1[1], c1[2], c1[3]}, sn[8] = {s0[0], s0[1], s0[2], s0[3], s1[0], s1[1], s1[2], s1[3]};
                float v[16];
#pragma unroll
                for (int bj = 0; bj < 2; ++bj)
#pragma unroll
                    for (int n = 0; n < 2; ++n)
#pragma unroll
                        for (int i = 0; i < 4; ++i) v[8 * bj + 4 * n + i] = acc[ai][bj][m][n][i];
                float ss = 0.f;
#pragma unroll
                for (int j = 0; j < 16; ++j) ss += v[j] * v[j];
                ss += __shfl_xor(ss, 16); ss += __shfl_xor(ss, 32); ss *= rr * rr;
                const float sc = rr / sqrtf(ss * (1.f / 64.f) + EPS);
#pragma unroll
                for (int j = 0; j < 16; ++j) v[j] *= sc * gn[j];
                if (fq == 0) {
#pragma unroll
                    for (int d = 0; d < 8; ++d) { const float x1 = v[d], x2 = v[d + 8]; v[d] = x1 * cs[d] - x2 * sn[d]; v[d + 8] = x1 * sn[d] + x2 * cs[d]; }
                }
                u32x4 w0, w1;
                w0.x = cvt_pk_bf16(v[0], v[1]); w0.y = cvt_pk_bf16(v[2], v[3]); w0.z = cvt_pk_bf16(v[4], v[5]); w0.w = cvt_pk_bf16(v[6], v[7]);
                w1.x = cvt_pk_bf16(v[8], v[9]); w1.y = cvt_pk_bf16(v[10], v[11]); w1.z = cvt_pk_bf16(v[12], v[13]); w1.w = cvt_pk_bf16(v[14], v[15]);
                *(u32x4*)rowp = w0; *(u32x4*)(rowp + 8) = w1; }
    }
};
struct EpiSwiGLU {
    static constexpr bool PERM = true; static constexpr bool PERM16 = false;
    bf16_t* O;
    __device__ __forceinline__ void operator()(const f32x4 (&acc)[2][2][4][2], const Unit& u, int wr, int wc, int fr, int fq) const {
        const int row0 = u.row0 + wr * 64 + fr, col0 = u.col0 + wc * 32 + 8 * fq;
#pragma unroll
        for (int ai = 0; ai < 2; ++ai)
#pragma unroll
            for (int m = 0; m < 4; ++m) { bf16_t* rowp = O + (size_t)(row0 + ai * HALF + m * 16) * DEXP + col0; const float rr = u.aux[wr * 64 + fr + ai * HALF + m * 16];
                float a[8];
#pragma unroll
                for (int n = 0; n < 2; ++n)
#pragma unroll
                    for (int j = 0; j < 4; ++j) { const float g = acc[ai][0][m][n][j] * rr, up = acc[ai][1][m][n][j] * rr;
                        a[n * 4 + j] = g * __builtin_amdgcn_rcpf(1.0f + __builtin_amdgcn_exp2f(-1.4426950408889634f * g)) * up; }
                u32x4 w; w.x = cvt_pk_bf16(a[0], a[1]); w.y = cvt_pk_bf16(a[2], a[3]); w.z = cvt_pk_bf16(a[4], a[5]); w.w = cvt_pk_bf16(a[6], a[7]);
                *(u32x4*)rowp = w; }
    }
};
struct EpiSwiGLU8 {
    static constexpr bool PERM = true; static constexpr bool PERM16 = false; static constexpr int NST = 8; static constexpr bool PRE8 = true; static constexpr bool TAKES_PRE8 = true;
    unsigned char* O; float asc;
    __device__ __forceinline__ float pre(const Unit& u, int wr, int fr, int q) const { return u.aux[wr * 64 + fr + (q >> 2) * HALF + (q & 3) * 16]; }
    __device__ __forceinline__ void operator()(const f32x4 (&acc)[2][2][4][2], const Unit& u, int wr, int wc, int fr, int fq, const float (&pre8)[8]) const {
        const int row0 = u.row0 + wr * 64 + fr, col0 = u.col0 + wc * 32 + 8 * fq;
#pragma unroll
        for (int ai = 0; ai < 2; ++ai)
#pragma unroll
            for (int m = 0; m < 4; ++m) { unsigned char* rowp = O + (size_t)(row0 + ai * HALF + m * 16) * DEXP + col0; const float rr = pre8[ai * 4 + m] * asc;
                float a[8];
#pragma unroll
                for (int n = 0; n < 2; ++n)
#pragma unroll
                    for (int j = 0; j < 4; ++j) { const float g = acc[ai][0][m][n][j] * rr, up = acc[ai][1][m][n][j] * rr;
                        a[n * 4 + j] = __builtin_amdgcn_fmed3f(8.0f * g * __builtin_amdgcn_rcpf(1.0f + __builtin_amdgcn_exp2f(-1.4426950408889634f * g)) * up, -440.0f, 440.0f); }
                int w0 = 0, w1 = 0;
                w0 = __builtin_amdgcn_cvt_pk_fp8_f32(a[0], a[1], w0, false); w0 = __builtin_amdgcn_cvt_pk_fp8_f32(a[2], a[3], w0, true);
                w1 = __builtin_amdgcn_cvt_pk_fp8_f32(a[4], a[5], w1, false); w1 = __builtin_amdgcn_cvt_pk_fp8_f32(a[6], a[7], w1, true);
                typedef unsigned u32x2 __attribute__((ext_vector_type(2)));
                *(u32x2*)rowp = (u32x2){(unsigned)w0, (unsigned)w1}; }
    }
};
struct EpiResBf16 {
    static constexpr bool PERM = true; static constexpr bool PERM16 = false; static constexpr bool PRE8 = false; static constexpr bool TAKES_PRE8 = false; static constexpr int NST = 16;
    bf16_t* X; float asc;
    __device__ __forceinline__ void operator()(const f32x4 (&acc)[2][2][4][2], const Unit& u, int wr, int wc, int fr, int fq) const {
        const int row0 = u.row0 + wr * 64 + fr, col0 = u.col0 + wc * 32 + 8 * fq;
#pragma unroll
        for (int ai = 0; ai < 2; ++ai)
#pragma unroll
            for (int m = 0; m < 4; ++m) { bf16_t* rowp = X + (size_t)(row0 + ai * HALF + m * 16) * D + col0;
                u32x4 xo[2];
#pragma unroll
                for (int bj = 0; bj < 2; ++bj) xo[bj] = *(const u32x4*)(rowp + bj * HALF);
#pragma unroll
                for (int bj = 0; bj < 2; ++bj) { const f32x4 v0 = acc[ai][bj][m][0], v1 = acc[ai][bj][m][1]; const u32x4 x = xo[bj];
                    u32x4 w;
                    w.x = cvt_pk_bf16(fmaf(v0[0], asc, __uint_as_float(x.x << 16)), fmaf(v0[1], asc, __uint_as_float(x.x & 0xffff0000u))); w.y = cvt_pk_bf16(fmaf(v0[2], asc, __uint_as_float(x.y << 16)), fmaf(v0[3], asc, __uint_as_float(x.y & 0xffff0000u)));
                    w.z = cvt_pk_bf16(fmaf(v1[0], asc, __uint_as_float(x.z << 16)), fmaf(v1[1], asc, __uint_as_float(x.z & 0xffff0000u))); w.w = cvt_pk_bf16(fmaf(v1[2], asc, __uint_as_float(x.w << 16)), fmaf(v1[3], asc, __uint_as_float(x.w & 0xffff0000u)));
                    *(u32x4*)(rowp + bj * HALF) = w; } }
    }
};

template <class Epi, class Sched, bool ALIGN_EPI = true, bool FP8 = false, int SCA = 127, int SCB = 127, bool PEEL = true>
__device__ __forceinline__ void gemm_phase(LAS unsigned char* lds, const int K, const Sched& S, const Epi& E, const int tid) {
    const int wid = __builtin_amdgcn_readfirstlane(tid >> 6), lane = tid & 63, wr = wid >> 2, wc = wid & 3, fr = lane & 15, fq = lane >> 4;
    const int nt = K / BK;
    unsigned voffA[2], voffB[2], voffB1[2];
#pragma unroll
    for (int i = 0; i < 2; ++i) { int R, C; if constexpr (FP8) stage_rc8(tid * 16 + i * 8192, R, C); else stage_rc(tid * 16 + i * 8192, R, C); const int Rb = Epi::PERM ? ((R & ~31) + perm32(R & 31)) : R;
        voffA[i] = (unsigned)(R * K + C) * 2u; voffB[i] = (unsigned)(Rb * K + C) * 2u; voffB1[i] = voffB[i];
        if constexpr (Epi::PERM16) {
            const int c0_ = 64 * (R >> 5) + 16 * ((R >> 2) & 3) + 4 * ((R >> 4) & 1) + (R & 3);
            voffB[i] = (unsigned)(c0_ * K + C) * 2u; voffB1[i] = (unsigned)((c0_ + 8) * K + C) * 2u; } }
    int gR[2]; unsigned gC2[2];
#pragma unroll
    for (int i = 0; i < 2; ++i) { int R, C; if constexpr (FP8) stage_rc8(tid * 16 + i * 8192, R, C); else stage_rc(tid * 16 + i * 8192, R, C); gR[i] = R; gC2[i] = (unsigned)C * 2u; }
    const size_t kstep = (size_t)(BK * 2);
    const size_t hstep = (size_t)HALF * K * 2;
    const size_t hstepB = Epi::PERM16 ? (size_t)0 : hstep;
    const unsigned ldsw = (unsigned)wid * 1024u;
    const int aoff = lds_byte(wr * 64 + fr, fq * 8), boff = lds_byte(wc * 32 + fr, fq * 8);
#define PG8_SA(b, h) (((b) * 2 + (h)) * HTB)
#define PG8_SB(b, h) ((4 + (b) * 2 + (h)) * HTB)
#define PG8_STAGE(bufoff, gbase, voff) do { _Pragma("unroll") for (int _i = 0; _i < 2; ++_i) \
        __builtin_amdgcn_global_load_lds((const unsigned*)((const char*)(gbase) + (voff)[_i]), (LAS unsigned*)(lds + (bufoff) + ldsw + _i * 8192), 16, 0, 0); } while (0)
#define PG8_LD8(p_) __builtin_shufflevector(*(const LAS v4i_t*)(p_), *(const LAS v4i_t*)((p_) + 1024), 0, 1, 2, 3, 4, 5, 6, 7)
#define PG8_LDA(dst, b, h) do { if constexpr (FP8) { _Pragma("unroll") for (int m = 0; m < 4; ++m) dst##8[m] = PG8_LD8(lds + PG8_SA(b, h) + aoff + m * 2048); } \
        else { _Pragma("unroll") for (int m = 0; m < 4; ++m) _Pragma("unroll") for (int k = 0; k < 2; ++k) dst[m][k] = *(const LAS bf16x8*)(lds + PG8_SA(b, h) + aoff + m * 2048 + k * 1024); } } while (0)
#define PG8_LDB(dst, b, h) do { if constexpr (FP8) { _Pragma("unroll") for (int n = 0; n < 2; ++n) dst##8[n] = PG8_LD8(lds + PG8_SB(b, h) + boff + n * 2048); } \
        else { _Pragma("unroll") for (int n = 0; n < 2; ++n) _Pragma("unroll") for (int k = 0; k < 2; ++k) dst[n][k] = *(const LAS bf16x8*)(lds + PG8_SB(b, h) + boff + n * 2048 + k * 1024); } } while (0)
#define PG8_MMA(ai, bj, At, Bt) do {   \
        if constexpr (FP8) { _Pragma("unroll") for (int m = 0; m < 4; ++m) _Pragma("unroll") for (int n = 0; n < 2; ++n) \
            asm volatile("v_mfma_f32_16x16x128_f8f6f4 %0, %1, %2, %0" : "+v"(acc[ai][bj][m][n]) : "v"(Bt##8[n]), "v"(At##8[m])); } \
        else { _Pragma("unroll") for (int k = 0; k < 2; ++k) _Pragma("unroll") for (int m = 0; m < 4; ++m) _Pragma("unroll") for (int n = 0; n < 2; ++n) \
            asm volatile("v_mfma_f32_16x16x32_bf16 %0, %1, %2, %0" : "+v"(acc[ai][bj][m][n]) : "v"(Bt[n][k]), "v"(At[m][k])); } \
        } while (0)
#define PG8_WAIT_V(n) asm volatile("s_waitcnt vmcnt(" #n ")" ::: "memory")
#define PG8_WAIT_L(n) asm volatile("s_waitcnt lgkmcnt(" #n ")" ::: "memory")
#define PG8_BAR __builtin_amdgcn_s_barrier()
#define PG8_SCHED __builtin_amdgcn_sched_barrier(0)
    Unit cur, nxt; int ui = 0;
    if (!S.next(0, cur)) return;
    f32x4 acc[2][2][4][2];
#pragma unroll
    for (int a = 0; a < 2; ++a)
#pragma unroll
        for (int b = 0; b < 2; ++b)
#pragma unroll
            for (int m = 0; m < 4; ++m)
#pragma unroll
                for (int n = 0; n < 2; ++n) { acc[a][b][m][n] = (f32x4){0.f, 0.f, 0.f, 0.f}; asm volatile("" : "+v"(acc[a][b][m][n])); }
    bf16x8 At[4][2], B0[2][2], B1[2][2];
    typedef int v8i_t __attribute__((ext_vector_type(8))); typedef int v4i_t __attribute__((ext_vector_type(4)));
    v8i_t At8[4], B08[2], B18[2];
    const char* cA = cur.A; const char* cB = cur.B;
    unsigned cvo[2][2], nvo[2][2];
#define PG8_GOFF(vo, un) do { _Pragma("unroll") for (int h_ = 0; h_ < 2; ++h_) _Pragma("unroll") for (int i_ = 0; i_ < 2; ++i_) { const int row_ = gR[i_] + HALF * h_; \
        const int tok_ = (row_ < (un).nvalid) ? (un).toks[row_] : 0; vo[h_][i_] = (unsigned)tok_ * (unsigned)(K * 2) + gC2[i_]; } } while (0)
    if constexpr (Sched::GATHER) { PG8_GOFF(cvo, cur); }
    if constexpr (Sched::GATHER) { PG8_STAGE(PG8_SB(0, 0), cB, voffB); PG8_STAGE(PG8_SB(0, 1), cB + hstepB, voffB1); PG8_STAGE(PG8_SA(0, 0), cA, cvo[0]); PG8_STAGE(PG8_SA(0, 1), cA, cvo[1]); }
    else { PG8_STAGE(PG8_SB(0, 0), cB, voffB); PG8_STAGE(PG8_SB(0, 1), cB + hstepB, voffB1); PG8_STAGE(PG8_SA(0, 0), cA, voffA); PG8_STAGE(PG8_SA(0, 1), cA + hstep, voffA); }
    if (wr == 1) PG8_BAR;
    PG8_WAIT_V(2); PG8_BAR;
    if constexpr (Sched::GATHER) { PG8_STAGE(PG8_SB(1, 0), cB + kstep, voffB); PG8_STAGE(PG8_SA(1, 0), cA + kstep, cvo[0]); PG8_STAGE(PG8_SB(1, 1), cB + hstepB + kstep, voffB1); }
    else { PG8_STAGE(PG8_SB(1, 0), cB + kstep, voffB); PG8_STAGE(PG8_SA(1, 0), cA + kstep, voffA); PG8_STAGE(PG8_SB(1, 1), cB + hstepB + kstep, voffB1); }
    PG8_WAIT_V(0); PG8_BAR;
    for (;;) {
        constexpr bool LATE_NEXT = PEEL && !Sched::GATHER;
        bool has_next = false; const char* nA = cA; const char* nB = cB;
        if constexpr (!LATE_NEXT) { has_next = S.next(ui + 1, nxt); nA = has_next ? nxt.A : cA; nB = has_next ? nxt.B : cB; }
        if constexpr (Sched::GATHER) {
            if (has_next) { PG8_GOFF(nvo, nxt); } else {
#pragma unroll
                for (int h_ = 0; h_ < 2; ++h_)
#pragma unroll
                    for (int i_ = 0; i_ < 2; ++i_) nvo[h_][i_] = cvo[h_][i_]; }
        }
#define PG8_TRIP(WV1) do { \
            const bool last = (t == nt - 2); \
            const char* b2 = last ? nB : cB + (size_t)(t + 2) * kstep; const char* b3 = b2 + kstep; \
            if constexpr (Sched::GATHER) { \
                const char* g1 = cA + (size_t)(t + 1) * kstep; const char* g2 = last ? cA : cA + (size_t)(t + 2) * kstep; const char* g3 = g2 + kstep; \
                unsigned x2[2][2]; \
                _Pragma("unroll") for (int h_ = 0; h_ < 2; ++h_) _Pragma("unroll") for (int i_ = 0; i_ < 2; ++i_) x2[h_][i_] = last ? nvo[h_][i_] : cvo[h_][i_]; \
                PG8_LDB(B0, 0, 0); PG8_LDB(B1, 0, 1); PG8_SCHED; PG8_LDA(At, 0, 0); PG8_STAGE(PG8_SA(1, 1), g1, cvo[1]); \
                PG8_WAIT_V(WV1); PG8_WAIT_L(0); PG8_BAR; PG8_MMA(0, 0, At, B0); PG8_MMA(0, 1, At, B1); PG8_BAR; PG8_SCHED; \
                PG8_LDA(At, 0, 1); PG8_STAGE(PG8_SB(0, 0), b2, voffB); PG8_STAGE(PG8_SB(0, 1), b2 + hstepB, voffB1); PG8_STAGE(PG8_SA(0, 0), g2, x2[0]); \
                PG8_WAIT_V(WV1); PG8_WAIT_L(0); PG8_BAR; PG8_MMA(1, 0, At, B0); PG8_MMA(1, 1, At, B1); PG8_BAR; PG8_SCHED; \
                PG8_LDB(B0, 1, 0); PG8_LDB(B1, 1, 1); PG8_SCHED; PG8_LDA(At, 1, 0); PG8_STAGE(PG8_SA(0, 1), g2, x2[1]); \
                PG8_WAIT_V(8); PG8_WAIT_L(0); PG8_BAR; PG8_MMA(0, 0, At, B0); PG8_MMA(0, 1, At, B1); PG8_BAR; PG8_SCHED; \
                PG8_LDA(At, 1, 1); PG8_STAGE(PG8_SB(1, 0), b3, voffB); PG8_STAGE(PG8_SB(1, 1), b3 + hstepB, voffB1); PG8_STAGE(PG8_SA(1, 0), g3, x2[0]); \
                PG8_WAIT_V(8); PG8_WAIT_L(0); PG8_BAR; PG8_MMA(1, 0, At, B0); PG8_MMA(1, 1, At, B1); PG8_BAR; PG8_SCHED; \
            } else { \
                const char* a1 = cA + (size_t)(t + 1) * kstep; const char* a2 = last ? nA : cA + (size_t)(t + 2) * kstep; const char* a3 = a2 + kstep; \
                PG8_LDB(B0, 0, 0); PG8_LDB(B1, 0, 1); PG8_SCHED; PG8_LDA(At, 0, 0); PG8_STAGE(PG8_SA(1, 1), a1 + hstep, voffA); \
                PG8_WAIT_V(WV1); PG8_WAIT_L(0); PG8_BAR; PG8_MMA(0, 0, At, B0); PG8_MMA(0, 1, At, B1); PG8_BAR; PG8_SCHED; \
                PG8_LDA(At, 0, 1); PG8_STAGE(PG8_SB(0, 0), b2, voffB); PG8_STAGE(PG8_SB(0, 1), b2 + hstepB, voffB1); PG8_STAGE(PG8_SA(0, 0), a2, voffA); \
                PG8_WAIT_V(WV1); PG8_WAIT_L(0); PG8_BAR; PG8_MMA(1, 0, At, B0); PG8_MMA(1, 1, At, B1); PG8_BAR; PG8_SCHED; \
                PG8_LDB(B0, 1, 0); PG8_LDB(B1, 1, 1); PG8_SCHED; PG8_LDA(At, 1, 0); PG8_STAGE(PG8_SA(0, 1), a2 + hstep, voffA); \
                PG8_WAIT_V(8); PG8_WAIT_L(0); PG8_BAR; PG8_MMA(0, 0, At, B0); PG8_MMA(0, 1, At, B1); PG8_BAR; PG8_SCHED; \
                PG8_LDA(At, 1, 1); PG8_STAGE(PG8_SB(1, 0), b3, voffB); PG8_STAGE(PG8_SB(1, 1), b3 + hstepB, voffB1); PG8_STAGE(PG8_SA(1, 0), a3, voffA); \
                PG8_WAIT_V(8); PG8_WAIT_L(0); PG8_BAR; PG8_MMA(1, 0, At, B0); PG8_MMA(1, 1, At, B1); PG8_BAR; PG8_SCHED; \
            } } while (0)
        if constexpr (PEEL) { int t = 0; PG8_TRIP(63); }
        if constexpr (LATE_NEXT) { has_next = S.next(ui + 1, nxt); nA = has_next ? nxt.A : cA; nB = has_next ? nxt.B : cB; }
#pragma unroll 1
        for (int t = PEEL ? 2 : 0; t < nt; t += 2) PG8_TRIP(8);
#undef PG8_TRIP
        float pre8[8];
        if constexpr (Epi::PRE8) {
#pragma unroll
            for (int q_ = 0; q_ < 8; ++q_) pre8[q_] = E.pre(cur, wr, fr, q_); }
        if constexpr (ALIGN_EPI) { if (wr == 0) PG8_BAR; }
        if constexpr (PEEL) PG8_WAIT_V(0);
        {
            asm volatile("s_nop 15\n\ts_nop 15" ::: "memory");
#pragma unroll
            for (int a = 0; a < 2; ++a)
#pragma unroll
                for (int b = 0; b < 2; ++b)
#pragma unroll
                    for (int m = 0; m < 4; ++m)
#pragma unroll
                        for (int n = 0; n < 2; ++n) asm volatile("" : "+v"(acc[a][b][m][n]));
        }
        if constexpr (Epi::TAKES_PRE8) E(acc, cur, wr, wc, fr, fq, pre8); else E(acc, cur, wr, wc, fr, fq);
        if (!has_next) break;
#pragma unroll
        for (int a = 0; a < 2; ++a)
#pragma unroll
            for (int b = 0; b < 2; ++b)
#pragma unroll
                for (int m = 0; m < 4; ++m)
#pragma unroll
                    for (int n = 0; n < 2; ++n) { acc[a][b][m][n] = (f32x4){0.f, 0.f, 0.f, 0.f}; asm volatile("" : "+v"(acc[a][b][m][n])); }
        cur = nxt; cA = nA; cB = nB; ++ui;
        if constexpr (Sched::GATHER) {
#pragma unroll
            for (int h_ = 0; h_ < 2; ++h_)
#pragma unroll
                for (int i_ = 0; i_ < 2; ++i_) cvo[h_][i_] = nvo[h_][i_]; }
        if constexpr (ALIGN_EPI) { if (wr == 1) PG8_BAR; }
    }
    PG8_WAIT_V(0);
    if constexpr (!ALIGN_EPI) { if (wr == 0) PG8_BAR; }
    PG8_BAR;
#undef PG8_GOFF
#undef PG8_SA
#undef PG8_SB
#undef PG8_STAGE
#undef PG8_LDA
#undef PG8_LD8
#undef PG8_LDB
#undef PG8_MMA
#undef PG8_WAIT_V
#undef PG8_WAIT_L
#undef PG8_BAR
#undef PG8_SCHED
}
}

constexpr size_t MiB = 1u << 20;
constexpr size_t WS_CTL = 0, CTL_ZERO_BYTES = 1 * MiB;
constexpr size_t WS_MISC = 1 * MiB;
constexpr size_t MISC_LAM = 0;
constexpr size_t MISC_LB = 1024;
constexpr size_t MISC_WRB = 64 * 1024;
constexpr size_t MISC_ROPE = 1 * MiB;
constexpr size_t MISC_TOKPOS = 6 * MiB;
constexpr size_t MISC_TOKGATE = 7 * MiB;
constexpr size_t MISC_TOKSLOT = 8 * MiB;
constexpr size_t MISC_TOKRSTD = 9 * MiB;
constexpr size_t MISC_SLOTRSTD = 10 * MiB;
constexpr size_t MISC_RSTDMIX = 11 * MiB;
constexpr size_t WS_WIN = 17 * MiB;
constexpr size_t WS_WOUT = 30 * MiB;
constexpr size_t WS_WGU = 34 * MiB;
constexpr size_t WS_WD = 162 * MiB;
constexpr size_t WS_U = 226 * MiB;
constexpr size_t WS_XG = WS_U, WS_ACT = WS_U + 272 * MiB;
constexpr size_t WS_X8 = WS_U + 344 * MiB;
constexpr size_t WS_X8B = 642 * MiB;
constexpr size_t WS_MIX = 642 * MiB;
constexpr size_t WS_XN = 770 * MiB;
constexpr size_t WS_LIST = 898 * MiB;
constexpr size_t WS_LRS = 906 * MiB;
constexpr size_t WS_END = 962 * MiB;
static_assert((size_t)CAP * 1024 * 2 <= 272 * MiB && (size_t)CAP * 512 * 2 <= 136 * MiB && (size_t)M * DIN * 2 <= 416 * MiB, "ws map");
constexpr int CW_BAR = 4096;
constexpr int CW_Q = 8192;
constexpr int CW_CNT = 16384;

constexpr int RING_OFF = 0, RING_BYTES = 131072;
constexpr int LDSCTL_OFF = RING_BYTES, MISC_OFF = LDSCTL_OFF + 320;
constexpr int TAB_OFF = LDSCTL_OFF + 1024;
constexpr int LDS_BYTES = 147456;

typedef unsigned short bf16;
typedef unsigned v4u __attribute__((ext_vector_type(4)));
typedef unsigned v2u __attribute__((ext_vector_type(2)));
typedef float f32x4 __attribute__((ext_vector_type(4)));
typedef float f32x2 __attribute__((ext_vector_type(2)));
typedef float f32x16 __attribute__((ext_vector_type(16)));
typedef short bf16x8 __attribute__((ext_vector_type(8)));
typedef short s16x4 __attribute__((ext_vector_type(4)));
typedef GAS unsigned gu32;
#define RLX_AGENT __ATOMIC_RELAXED, __HIP_MEMORY_SCOPE_AGENT
#define LDS_WAIT() asm volatile("s_waitcnt lgkmcnt(0)" ::: "memory")
#define VM_WAIT() asm volatile("s_waitcnt vmcnt(0)" ::: "memory")
typedef float f32x2_t __attribute__((ext_vector_type(2))); typedef __bf16 bf16x2_t __attribute__((ext_vector_type(2)));
__device__ __forceinline__ unsigned pk2(float lo, float hi) { f32x2_t v = {lo, hi}; bf16x2_t b = __builtin_convertvector(v, bf16x2_t); return __builtin_bit_cast(unsigned, b); }
__device__ __forceinline__ float bflo(unsigned w) { return __uint_as_float(w << 16); }
__device__ __forceinline__ float bfhi(unsigned w) { return __uint_as_float(w & 0xffff0000u); }
constexpr float MIXSC = 4.0f;
__device__ __forceinline__ float fp8c(float x) { return __builtin_amdgcn_fmed3f(x, -440.0f, 440.0f); }
__device__ __forceinline__ v2u pk8_fp8(const float (&v)[8]) { int w0 = 0, w1 = 0;
    w0 = __builtin_amdgcn_cvt_pk_fp8_f32(fp8c(v[0] * MIXSC), fp8c(v[1] * MIXSC), w0, false); w0 = __builtin_amdgcn_cvt_pk_fp8_f32(fp8c(v[2] * MIXSC), fp8c(v[3] * MIXSC), w0, true);
    w1 = __builtin_amdgcn_cvt_pk_fp8_f32(fp8c(v[4] * MIXSC), fp8c(v[5] * MIXSC), w1, false); w1 = __builtin_amdgcn_cvt_pk_fp8_f32(fp8c(v[6] * MIXSC), fp8c(v[7] * MIXSC), w1, true);
    return (v2u){(unsigned)w0, (unsigned)w1}; }
__device__ __forceinline__ float fsigmoid(float z) { return __builtin_amdgcn_rcpf(1.0f + __builtin_amdgcn_exp2f(-1.4426950408889634f * z)); }

#define XB_TMO      128
#define XB_XCNT(j)  (256  + 64 * (j))
#define XB_XSUB(j)  (1280 + 64 * (j))
#define XB_XGEN(j)  (2304 + 64 * (j))
#define XB_TOP      3328
#define XB_TOPGEN   3392
#define XCD_BAR_WORDS 3456
#define XB_SPIN_CAP (1u << 18)
__device__ __forceinline__ unsigned xb_ld(unsigned* p)              { return __hip_atomic_load(p, __ATOMIC_RELAXED, __HIP_MEMORY_SCOPE_AGENT); }
__device__ __forceinline__ unsigned xb_add(unsigned* p, unsigned v) { return __hip_atomic_fetch_add(p, v, __ATOMIC_RELAXED, __HIP_MEMORY_SCOPE_AGENT); }
__device__ __forceinline__ unsigned xb_xcc_id() { return (unsigned)__builtin_amdgcn_s_getreg((3 << 11) | 20) & 0xFu; }
#define XB_SPIN(cond, bar) do { unsigned _sp = 0; while (cond) { __builtin_amdgcn_s_sleep(1); \
    if ((++_sp & 255u) == 0u) { if (xb_ld(&(bar)[XB_TMO])) break; if (_sp > XB_SPIN_CAP) { atomicAdd(&(bar)[XB_TMO], 1u); break; } } } } while (0)
struct XcdBarrier { unsigned* bar; unsigned x; volatile LAS unsigned* st; };
__device__ __forceinline__ XcdBarrier xcd_barrier_post(unsigned* bar, volatile LAS unsigned* st) {
    XcdBarrier b; b.bar = bar; b.x = xb_xcc_id(); b.st = st;
    if (threadIdx.x == 0) (void)xb_add(&bar[XB_XCNT(b.x)], 1u);
    return b;
}
__device__ __forceinline__ void xcd_barrier_complete(unsigned* bar, unsigned x, unsigned& nloc, unsigned& nx) {
    const unsigned G = gridDim.x * gridDim.y * gridDim.z;
    unsigned sum, cnt, mine, sp = 0u;
    for (;;) {
        sum = 0u; cnt = 0u; mine = 0u;
#pragma unroll
        for (unsigned j = 0; j < 16; ++j) { const unsigned c = xb_ld(&bar[XB_XCNT(j)]); sum += c; cnt += (c > 0u) ? 1u : 0u; mine = (j == x) ? c : mine; }
        if (sum == G) break;
        __builtin_amdgcn_s_sleep(1);
        if ((++sp & 255u) == 0u) { if (xb_ld(&bar[XB_TMO])) break; if (sp > XB_SPIN_CAP) { atomicAdd(&bar[XB_TMO], 1u); break; } }
    }
    nloc = mine > 0u ? mine : 1u; nx = cnt > 0u ? cnt : 1u;
}
__device__ __forceinline__ void xcd_barrier(const XcdBarrier& b) {
    asm volatile("s_waitcnt vmcnt(0)" ::: "memory");
    __syncthreads();
    if (threadIdx.x == 0) {
        unsigned* bar = b.bar; asm volatile("" : "+s"(bar));
        __builtin_amdgcn_s_waitcnt(0);
        unsigned nloc = b.st[0], nx = b.st[1];
        if (nloc == 0u) { xcd_barrier_complete(bar, b.x, nloc, nx); b.st[0] = nloc; b.st[1] = nx; }
        const unsigned old = xb_add(&bar[XB_XSUB(b.x)], 1u);
        const unsigned gen = old / nloc;
        if (old + 1u == (gen + 1u) * nloc) {
            __builtin_amdgcn_fence(__ATOMIC_RELEASE, "agent");
            asm volatile("s_waitcnt vmcnt(0)" ::: "memory");
            const unsigned og = xb_add(&bar[XB_TOP], 1u);
            const unsigned tg = og / nx;
            if (og + 1u == (tg + 1u) * nx) xb_add(&bar[XB_TOPGEN], 1u);
            else XB_SPIN(xb_ld(&bar[XB_TOPGEN]) == tg, bar);
            __builtin_amdgcn_fence(__ATOMIC_ACQUIRE, "agent");
            xb_add(&bar[XB_XGEN(b.x)], 1u);
            asm volatile("s_waitcnt vmcnt(0)" ::: "memory");
        } else {
            XB_SPIN(xb_ld(&bar[XB_XGEN(b.x)]) == gen, bar);
            __builtin_amdgcn_fence(__ATOMIC_ACQUIRE, "agent");
            asm volatile("s_waitcnt vmcnt(0)" ::: "memory");
        }
    }
    __syncthreads();
}

struct Args { const float* in[23]; float* out; unsigned char* ws; int ph_lo, ph_hi; };
struct Frame {
    LAS unsigned char* lds;
    volatile LAS unsigned* MISC;
    gu32* ctl;
    int tid, lane, wave;
    int vcu, G, bx;
    float* out; unsigned char* ws;
};
__device__ __forceinline__ float wave_sum(float v) {
#pragma unroll
    for (int o = 1; o < 64; o <<= 1) v += __shfl_xor(v, o);
    return v;
}

__device__ __forceinline__ void wt_load(const float* W, int N, int k0, int n0, const float* kscale, int lane, f32x4 (&wv)[8], float (&kv)[8]) {
    const float* p = W + (size_t)(k0 + (lane >> 3)) * N + n0 + 4 * (lane & 7);
#pragma unroll
    for (int j = 0; j < 8; ++j) wv[j] = *(const GAS f32x4*)(p + (size_t)(8 * j) * N);
#pragma unroll
    for (int j = 0; j < 8; ++j) kv[j] = kscale ? kscale[k0 + 8 * j + (lane >> 3)] : 1.0f;
}
__device__ __forceinline__ void wt_to_lds(const f32x4 (&wv)[8], const float (&kv)[8], float wmul, LAS float* scr, int lane) {
#pragma unroll
    for (int j = 0; j < 8; ++j) { LAS float* q = scr + (8 * j + (lane >> 3)) * 33 + 4 * (lane & 7); const float m = kv[j] * wmul; q[0] = wv[j].x * m; q[1] = wv[j].y * m; q[2] = wv[j].z * m; q[3] = wv[j].w * m; }
    LDS_WAIT(); asm volatile("" ::: "memory");
}
__device__ __forceinline__ void wt_store_bf16(bf16* WT, int K, int dst_row0, int k0, LAS float* scr, int lane) {
    const int c = lane & 7;
#pragma unroll
    for (int j = 0; j < 4; ++j) { const int n = (lane >> 3) + 8 * j; const LAS float* s = scr + (8 * c) * 33 + n;
        v4u o; o.x = pk2(s[0 * 33], s[1 * 33]); o.y = pk2(s[2 * 33], s[3 * 33]); o.z = pk2(s[4 * 33], s[5 * 33]); o.w = pk2(s[6 * 33], s[7 * 33]);
        *(GAS v4u*)(WT + (size_t)(dst_row0 + n) * K + k0 + 8 * c) = o; }
    LDS_WAIT(); asm volatile("" ::: "memory");
}
__device__ __forceinline__ void wt_store_fp8(unsigned char* WT, int K, int dst_row0, int k0, LAS float* scr, int lane) {
    const int n = lane & 31, kh = lane >> 5; const LAS float* sp = scr + (32 * kh) * 33 + n;
    unsigned w[8];
#pragma unroll
    for (int q = 0; q < 8; ++q) { int t = 0; t = __builtin_amdgcn_cvt_pk_fp8_f32(sp[(4 * q) * 33], sp[(4 * q + 1) * 33], t, false); t = __builtin_amdgcn_cvt_pk_fp8_f32(sp[(4 * q + 2) * 33], sp[(4 * q + 3) * 33], t, true); w[q] = (unsigned)t; }
    unsigned char* dst = WT + (size_t)(dst_row0 + n) * K + k0 + 32 * kh;
    *(GAS v4u*)dst = (v4u){w[0], w[1], w[2], w[3]}; *(GAS v4u*)(dst + 16) = (v4u){w[4], w[5], w[6], w[7]};
    LDS_WAIT(); asm volatile("" ::: "memory");
}
__device__ __forceinline__ void p0_transpose_item(const float* W, int K, int N, bf16* WT, int dst_row0, int k0, int n0, LAS float* scr, int lane, const float* kscale = nullptr) {
    f32x4 wv[8]; float kv[8];
    wt_load(W, N, k0, n0, kscale, lane, wv, kv); wt_to_lds(wv, kv, 1.0f, scr, lane); wt_store_bf16(WT, K, dst_row0, k0, scr, lane);
}
__device__ __forceinline__ void p0_transpose_item8(const float* W, int K, int N, unsigned char* WT, int dst_row0, int k0, int n0, LAS float* scr, int lane, const float* kscale, float wmul) {
    f32x4 wv[8]; float kv[8];
    wt_load(W, N, k0, n0, kscale, lane, wv, kv); wt_to_lds(wv, kv, wmul, scr, lane); wt_store_fp8(WT, K, dst_row0, k0, scr, lane);
}
__device__ __forceinline__ void row_to_bf16_rstd(const float* xrow, bf16* orow, float* rs, int lane) {
    const GAS f32x4* xr = (const GAS f32x4*)xrow + 2 * lane;
    f32x4 v[4]; float s = 0.f;
#pragma unroll
    for (int j = 0; j < 2; ++j) { v[2 * j] = xr[128 * j]; v[2 * j + 1] = xr[128 * j + 1]; }
#pragma unroll
    for (int j = 0; j < 4; ++j) s += (v[j].x * v[j].x + v[j].y * v[j].y) + (v[j].z * v[j].z + v[j].w * v[j].w);
    const float rstd = 1.0f / sqrtf(wave_sum(s) * (1.f / D) + EPS);
    GAS v4u* o16 = (GAS v4u*)orow + lane;
#pragma unroll
    for (int j = 0; j < 2; ++j) o16[64 * j] = (v4u){pk2(v[2 * j].x, v[2 * j].y), pk2(v[2 * j].z, v[2 * j].w), pk2(v[2 * j + 1].x, v[2 * j + 1].y), pk2(v[2 * j + 1].z, v[2 * j + 1].w)};
    if (lane == 0) *rs = rstd;
}
constexpr int I_WIN = 16 * 104, I_WOUT = 16 * 32, I_G = 16 * 16, I_D = 8 * 32;
constexpr int ITEMS_PER_LAYER = I_WIN + I_WOUT + 2 * 32 * I_G + 32 * I_D;
__device__ __forceinline__ void weight_item(const Args& A, unsigned char* ws, int l, int r, LAS float* scr, int lane) {
    if (r < I_WIN) { const int kb = r / 104, nb = r % 104;
        if (l == 0) p0_transpose_item(A.in[3], D, DIN, (bf16*)(ws + WS_WIN), 32 * nb, 64 * kb, 32 * nb, scr, lane, A.in[2]);
        else p0_transpose_item8(A.in[3] + (size_t)l * D * DIN, D, DIN, ws + WS_WIN + (size_t)DIN * D * 2, 32 * nb, 64 * kb, 32 * nb, scr, lane, A.in[2] + l * D, 32.0f);
        return; } r -= I_WIN;
    if (r < I_WOUT) { const int kb = r / 32, nb = r % 32;
        if (l == 0) p0_transpose_item(A.in[14], D, D, (bf16*)(ws + WS_WOUT), 32 * nb, 64 * kb, 32 * nb, scr, lane);
        else p0_transpose_item8(A.in[14] + (size_t)l * D * D, D, D, ws + WS_WOUT + 2 * MiB, 32 * nb, 64 * kb, 32 * nb, scr, lane, nullptr, 32.0f);
        return; } r -= I_WOUT;
    if (r < 32 * I_G) { const int le = l * 32 + r / I_G, q = r % I_G, kb = q / 16, nb = q % 16, n0 = 32 * nb;
        p0_transpose_item8(A.in[20] + (size_t)le * D * DEXP, D, DEXP, ws + WS_WGU + (size_t)le * D * D, (n0 >> 7) * 256 + (n0 & 127), 64 * kb, n0, scr, lane, A.in[15] + l * D, 32.0f); return; } r -= 32 * I_G;
    if (r < 32 * I_G) { const int le = l * 32 + r / I_G, q = r % I_G, kb = q / 16, nb = q % 16, n0 = 32 * nb;
        p0_transpose_item8(A.in[21] + (size_t)le * D * DEXP, D, DEXP, ws + WS_WGU + (size_t)le * D * D, (n0 >> 7) * 256 + 128 + (n0 & 127), 64 * kb, n0, scr, lane, A.in[15] + l * D, 32.0f); return; } r -= 32 * I_G;
    { const int le = l * 32 + r / I_D, q = r % I_D, kb = q / 32, nb = q % 32;
        p0_transpose_item8(A.in[22] + (size_t)le * DEXP * D, DEXP, D, ws + WS_WD + (size_t)le * D * DEXP, 32 * nb, 64 * kb, 32 * nb, scr, lane, nullptr, 16.0f); }
}
struct WItem { const float* W; const float* ks; unsigned char* dst; int N, Kp, k0, n0, drow, kind; float wmul; };
__device__ __forceinline__ void witem_desc(const Args& A, unsigned char* ws, int it, WItem& d) {
    constexpr int N_DEF_ = (ITEMS_PER_LAYER - I_WIN) + ITEMS_PER_LAYER;
    d.kind = -1; d.W = A.in[3]; d.ks = nullptr; d.dst = ws; d.N = 0; d.Kp = 0; d.k0 = 0; d.n0 = 0; d.drow = 0; d.wmul = 1.0f;
    int l, r;
    if (it < ITEMS_PER_LAYER - I_WIN) { l = 0; r = I_WIN + it; } else if (it < N_DEF_) { l = 1; r = it - (ITEMS_PER_LAYER - I_WIN); } else return;
    if (r < I_WIN) { const int kb = r / 104, nb = r % 104; d.N = DIN; d.Kp = D; d.k0 = 64 * kb; d.n0 = 32 * nb; d.drow = 32 * nb; d.ks = A.in[2] + l * D;
        if (l == 0) { d.kind = 0; d.W = A.in[3]; d.dst = ws + WS_WIN; } else { d.kind = 1; d.W = A.in[3] + (size_t)l * D * DIN; d.dst = ws + WS_WIN + (size_t)DIN * D * 2; d.wmul = 32.0f; }
        return; }
    r -= I_WIN;
    if (r < I_WOUT) { const int kb = r / 32, nb = r % 32; d.N = D; d.Kp = D; d.k0 = 64 * kb; d.n0 = 32 * nb; d.drow = 32 * nb;
        if (l == 0) { d.kind = 0; d.W = A.in[14]; d.dst = ws + WS_WOUT; } else { d.kind = 1; d.W = A.in[14] + (size_t)l * D * D; d.dst = ws + WS_WOUT + 2 * MiB; d.wmul = 32.0f; }
        return; }
    r -= I_WOUT;
    if (r < 2 * 32 * I_G) { const int up = (r >= 32 * I_G) ? 1 : 0; r -= up * 32 * I_G;
        const int le = l * 32 + r / I_G, q = r % I_G, kb = q / 16, nb = q % 16, n0 = 32 * nb;
        d.kind = 1; d.W = (up ? A.in[21] : A.in[20]) + (size_t)le * D * DEXP; d.N = DEXP; d.Kp = D; d.dst = ws + WS_WGU + (size_t)le * D * D; d.drow = (n0 >> 7) * 256 + up * 128 + (n0 & 127); d.k0 = 64 * kb; d.n0 = n0;
        d.ks = A.in[15] + l * D; d.wmul = 32.0f; return; }
    r -= 2 * 32 * I_G;
    { const int le = l * 32 + r / I_D, q = r % I_D, kb = q / 32, nb = q % 32;
      d.kind = 1; d.W = A.in[22] + (size_t)le * DEXP * D; d.N = D; d.Kp = DEXP; d.dst = ws + WS_WD + (size_t)le * D * DEXP; d.drow = 32 * nb; d.k0 = 64 * kb; d.n0 = 32 * nb; d.wmul = 16.0f; }
}
__device__ __forceinline__ void witem_finish(const WItem& d, const f32x4 (&wv)[8], const float (&kv)[8], LAS float* scr, int lane) {
    if (d.kind < 0) return;
    wt_to_lds(wv, kv, d.wmul, scr, lane);
    if (d.kind == 0) wt_store_bf16((bf16*)d.dst, d.Kp, d.drow, d.k0, scr, lane); else wt_store_fp8(d.dst, d.Kp, d.drow, d.k0, scr, lane);
}
__device__ __forceinline__ void p0_prologue(const Args& A, Frame& F) {
    LAS float* scr = (LAS float*)(F.lds + RING_OFF + F.wave * 16384);
    const int gw = F.vcu * 8 + F.wave, NGW = F.G * 8;
    unsigned char* ws = F.ws;
    for (int it = gw; it < I_WIN; it += NGW) weight_item(A, ws, 0, it, scr, F.lane);
    const int gt = F.vcu * 512 + F.tid, NGT = F.G * 512;
    { bf16* WrB = (bf16*)(ws + WS_MISC + MISC_WRB);
      for (int i = gt; i < 2 * 64 * 1024; i += NGT) { const int l = i / (64 * 1024), o = (i / 1024) % 64, k = i % 1024;
          float w = (o < 32) ? A.in[18][((size_t)l * D + k) * 32 + o] : (o < 36 ? A.in[16][((size_t)l * D + k) * 4 + (o - 32)] : 0.f);
          w *= A.in[15][l * D + k];
          const unsigned hb = pk2(w, 0.f) & 0xffffu; const float lo = w - __uint_as_float(hb << 16);
          const size_t base = (size_t)(l * 16 + (k >> 6)) * 8192 + (size_t)((k & 63) >> 3) * 256 + (o & 31) * 8 + (k & 7);
          WrB[base + (size_t)((o >> 5) * 2 + 0) * 2048] = (bf16)hb; WrB[base + (size_t)((o >> 5) * 2 + 1) * 2048] = (bf16)(pk2(lo, 0.f) & 0xffffu); } }
    { float* rope = (float*)(ws + WS_MISC + MISC_ROPE); const int* pos = (const int*)A.in[1];
      for (int i = gt; i < M * 8; i += NGT) { const int m = i >> 3, f = i & 7;
          const float invf = exp2f(-(float)f * (18.931568569324174f / 8.0f));
          const float ang = (float)pos[m] * invf; float sn, cs; sincosf(ang, &sn, &cs);
          rope[(size_t)m * 16 + f] = cs; rope[(size_t)m * 16 + 8 + f] = sn; } }
    if (gt < 2) { const int l = gt; float s1 = 0.f, s2 = 0.f;
        for (int i = 0; i < 64; ++i) { s1 += A.in[6][l * 64 + i] * A.in[7][l * 64 + i]; s2 += A.in[8][l * 64 + i] * A.in[9][l * 64 + i]; }
        const float lam_init = 0.8f - 0.6f * expf(-0.3f * (float)l);
        ((float*)(ws + WS_MISC + MISC_LAM))[l] = expf(s1) - expf(s2) + lam_init; }
    if (gt >= 512 && gt < 512 + 256) { const int j = gt - 512; const float h0 = A.in[11][j], h1 = A.in[11][256 + j];
        float* lb = (float*)(ws + WS_MISC + MISC_LB); lb[j] = 0.f; lb[256 + j] = 1.0f / (1.0f + expf(h0 - h1)); }
    for (int m = gw; m < M; m += NGW) row_to_bf16_rstd(A.in[0] + (size_t)m * D, (bf16*)(ws + WS_XN) + (size_t)m * D, (float*)(ws + WS_MISC + MISC_RSTDMIX) + m, F.lane);
}

__device__ __forceinline__ void conv_unit(const Args& A, Frame& F, int l, int cu) {
    const int lane = F.lane, ch = (lane & 31) * 8, half = lane >> 5;
    const bf16* u = (const bf16*)(F.ws + WS_U); bf16* mix = (bf16*)(F.ws + WS_MIX);
    const float* cw = A.in[13] + (size_t)l * 3 * 256 + ch;
    float w0[8], w1[8], w2[8];
#pragma unroll
    for (int j = 0; j < 8; ++j) { w0[j] = cw[j]; w1[j] = cw[256 + j]; w2[j] = cw[512 + j]; }
    const int m0 = cu * 256 + F.wave * 32 + half;
#define CV_H(dst, rowp) do { const v4u c_ = *(const GAS v4u*)((rowp) + CC + ch), x_ = *(const GAS v4u*)((rowp) + CX + ch); const unsigned cw_[4] = {c_.x, c_.y, c_.z, c_.w}, xw_[4] = {x_.x, x_.y, x_.z, x_.w}; \
        _Pragma("unroll") for (int q = 0; q < 4; ++q) { dst[2 * q] = bflo(cw_[q]) * bflo(xw_[q]); dst[2 * q + 1] = bfhi(cw_[q]) * bfhi(xw_[q]); } } while (0)
    for (int i = 0; i < 16; ++i) {
        const int m = m0 + 2 * i; const bf16* row = u + (size_t)m * DIN;
        const int s = m & (SEQ - 1);
        const v4u cbv = *(const GAS v4u*)(row + CB + ch);
        float h0[8], h1[8], h2[8];
#pragma unroll
        for (int j = 0; j < 8; ++j) { h0[j] = 0.f; h1[j] = 0.f; }
        CV_H(h2, row);
        if (s >= 1) CV_H(h1, row - DIN);
        if (s >= 2) CV_H(h0, row - 2 * DIN);
        const unsigned bw[4] = {cbv.x, cbv.y, cbv.z, cbv.w};
        float y[8];
#pragma unroll
        for (int q = 0; q < 4; ++q) { y[2 * q] = bflo(bw[q]) * (w0[2 * q] * h0[2 * q] + w1[2 * q] * h1[2 * q] + w2[2 * q] * h2[2 * q]); y[2 * q + 1] = bfhi(bw[q]) * (w0[2 * q + 1] * h0[2 * q + 1] + w1[2 * q + 1] * h1[2 * q + 1] + w2[2 * q + 1] * h2[2 * q + 1]); }
        if (l == 0) *(GAS v4u*)(mix + (size_t)m * D + 768 + ch) = (v4u){pk2(y[0], y[1]), pk2(y[2], y[3]), pk2(y[4], y[5]), pk2(y[6], y[7])};
        else *(GAS v2u*)((unsigned char*)mix + (size_t)m * D + 768 + ch) = pk8_fp8(y);
    }
#undef CV_H
}

__device__ __forceinline__ int crow(int r, int hi) { return (r & 3) + 8 * (r >> 2) + 4 * hi; }
typedef short v4i16_t __attribute__((ext_vector_type(4)));
__device__ __forceinline__ s16x4 vtr(const LAS unsigned char* p) { return __builtin_bit_cast(s16x4, __builtin_amdgcn_ds_read_tr16_b64_v4i16((LAS v4i16_t*)p)); }
constexpr int XS = 132;
__device__ __forceinline__ void attn_unit(Frame& F, const bf16* u, bf16* mix, int b, int h, int rb, float lam, float oscale, const float* subg, const bool mix8) {
    const int lane = F.lane, r32 = lane & 31, hi = lane >> 5, wid = F.wave, rg = wid & 3, comp = wid >> 2;
    const size_t rowb = (size_t)b * SEQ; const int t0 = rb * 128;
    const int NT = 2 * rb + 2, ntw = 2 * rb + (rg >> 1) + 1;
    LAS unsigned char* lds = F.lds;
    const int kr = 8 * wid + (lane >> 3);
    const bf16* ksrc0 = u + (rowb + kr) * DIN + AK + h * 128 + (((lane & 7) ^ ((kr >> 1) & 7)) * 8);
    const bf16* ksrc1 = ksrc0 + 64;
    const int vr = 8 * wid + (lane >> 4);
    const bf16* vsrcA = u + (rowb + vr) * DIN + AV + h * 128 + ((((lane & 15) >> 2) ^ (vr & 3)) * 32) + (lane & 3) * 8;
    const bf16* vsrcB = vsrcA + 4 * DIN;
#define ATT_DMA_K(j, s) do { const size_t go = (size_t)(j) * 64 * DIN; LAS unsigned char* sb = lds + (s) * 16384 + wid * 1024; \
        __builtin_amdgcn_global_load_lds((const unsigned*)(ksrc0 + go), (LAS unsigned*)(sb), 16, 0, 0); \
        __builtin_amdgcn_global_load_lds((const unsigned*)(ksrc1 + go), (LAS unsigned*)(sb + 8192), 16, 0, 0); } while (0)
#define ATT_DMA_V(j, s) do { const size_t go = (size_t)(j) * 64 * DIN; LAS unsigned char* sb = lds + 65536 + (s) * 16384 + wid * 2048; \
        __builtin_amdgcn_global_load_lds((const unsigned*)(vsrcA + go), (LAS unsigned*)(sb), 16, 0, 0); \
        __builtin_amdgcn_global_load_lds((const unsigned*)(vsrcB + go), (LAS unsigned*)(sb + 1024), 16, 0, 0); } while (0)
#define ATT_QK(P0, P1, s) do { const LAS unsigned char* Kb = lds + (s) * 16384 + comp * 8192 + r32 * 128; bf16x8 kf[8]; \
        _Pragma("unroll") for (int d0 = 0; d0 < 4; ++d0) { kf[2 * d0] = *(const LAS bf16x8*)(Kb + koff[d0]); kf[2 * d0 + 1] = *(const LAS bf16x8*)(Kb + koff[d0] + 4096); } \
        __builtin_amdgcn_sched_barrier(0); \
        _Pragma("unroll") for (int r = 0; r < 16; ++r) { P0[r] = 0.f; P1[r] = 0.f; } \
        _Pragma("unroll") for (int d0 = 0; d0 < 4; ++d0) { \
            P0 = __builtin_amdgcn_mfma_f32_32x32x16_bf16(kf[2 * d0], qr[d0], P0, 0, 0, 0); \
            P1 = __builtin_amdgcn_mfma_f32_32x32x16_bf16(kf[2 * d0 + 1], qr[d0], P1, 0, 0, 0); } } while (0)
#define ATT_TRR(dst, va_, off) asm volatile("ds_read_b64_tr_b16 %0, %1 offset:%2" : "=&v"(dst) : "v"(va_), "i"(off) : "memory")
#define ATT_VRD(buf, cb) do { const unsigned va_ = vaddr ^ ((unsigned)(cb) << 6); _Pragma("unroll") for (int ks_ = 0; ks_ < 4; ++ks_) { ATT_TRR(buf[2 * ks_], va_, ks_ * 4096); ATT_TRR(buf[2 * ks_ + 1], va_, ks_ * 4096 + 2048); } } while (0)
#define ATT_PV(buf, cb) do { _Pragma("unroll") for (int ks_ = 0; ks_ < 4; ++ks_) { const bf16x8 vf_ = {buf[2 * ks_][0], buf[2 * ks_][1], buf[2 * ks_][2], buf[2 * ks_][3], buf[2 * ks_ + 1][0], buf[2 * ks_ + 1][1], buf[2 * ks_ + 1][2], buf[2 * ks_ + 1][3]}; \
        o[cb] = __builtin_amdgcn_mfma_f32_32x32x16_bf16(__builtin_bit_cast(bf16x8, pw[ks_]), vf_, o[cb], 0, 0, 0); } } while (0)
#define ATT_FADD(d_, a_, b_) asm("v_add_f32 %0, %1, %2" : "=v"(d_) : "v"(a_), "v"(b_))
#define ATT_EXPSUM(pa_, pb_, sa_, sb_) asm("v_exp_f32 %0, %0\n\tv_exp_f32 %1, %1\n\tv_add_f32 %2, %2, %0\n\tv_add_f32 %3, %3, %1" : "+v"(pa_), "+v"(pb_), "+v"(sa_), "+v"(sb_))
#define ATT_SOFTMAX() do { float s0_ = 0.f, s1_ = 0.f; \
        _Pragma("unroll") for (int r = 0; r < 16; ++r) ATT_EXPSUM(p0[r], p1[r], s0_, s1_); \
        ATT_FADD(s0_, s0_, s1_); ATT_FADD(lsum, lsum, s0_); \
        pw[0] = (v4u){pk2(p0[0], p0[1]), pk2(p0[2], p0[3]), pk2(p0[4], p0[5]), pk2(p0[6], p0[7])}; \
        pw[1] = (v4u){pk2(p0[8], p0[9]), pk2(p0[10], p0[11]), pk2(p0[12], p0[13]), pk2(p0[14], p0[15])}; \
        pw[2] = (v4u){pk2(p1[0], p1[1]), pk2(p1[2], p1[3]), pk2(p1[4], p1[5]), pk2(p1[6], p1[7])}; \
        pw[3] = (v4u){pk2(p1[8], p1[9]), pk2(p1[10], p1[11]), pk2(p1[12], p1[13]), pk2(p1[14], p1[15])}; } while (0)
#define ATT_PVALL(vst) do { const unsigned vaddr = (unsigned)(uintptr_t)(lds + 65536 + (vst) * 16384) + vlane; s16x4 va[8], vb[8]; \
        ATT_VRD(va, 0); ATT_VRD(vb, 1); \
        asm volatile("s_waitcnt lgkmcnt(8)" ::: "memory"); __builtin_amdgcn_sched_barrier(0); ATT_PV(va, 0); __builtin_amdgcn_sched_barrier(0); \
        ATT_VRD(va, 2); \
        asm volatile("s_waitcnt lgkmcnt(8)" ::: "memory"); __builtin_amdgcn_sched_barrier(0); ATT_PV(vb, 1); __builtin_amdgcn_sched_barrier(0); \
        ATT_VRD(vb, 3); \
        asm volatile("s_waitcnt lgkmcnt(8)" ::: "memory"); __builtin_amdgcn_sched_barrier(0); ATT_PV(va, 2); __builtin_amdgcn_sched_barrier(0); \
        asm volatile("s_waitcnt lgkmcnt(0)" ::: "memory"); __builtin_amdgcn_sched_barrier(0); ATT_PV(vb, 3); __builtin_amdgcn_sched_barrier(0); } while (0)
    ATT_DMA_K(0, 0); ATT_DMA_V(0, 0); ATT_DMA_K(1, 1); ATT_DMA_V(1, 1); if (NT > 2) ATT_DMA_K(2, 2);
    const bf16* qp = u + (rowb + t0 + 32 * rg + r32) * DIN + AQ + h * 128 + comp * 64 + hi * 8;
    bf16x8 qr[4];
#pragma unroll
    for (int d0 = 0; d0 < 4; ++d0) qr[d0] = *(const GAS bf16x8*)(qp + d0 * 16);
    f32x16 o[4];
#pragma unroll
    for (int c = 0; c < 4; ++c)
#pragma unroll
        for (int r = 0; r < 16; ++r) o[c][r] = 0.f;
    float lsum = 0.f;
    VM_WAIT(); __syncthreads();
    f32x16 p0, p1;
    v4u pw[4];
    const unsigned vlane = (4 * hi + ((lane & 15) >> 2)) * 256 + (((lane & 15) >> 2) << 6) + ((lane >> 4) & 1) * 32 + (lane & 3) * 8;
    unsigned koff[4];
#pragma unroll
    for (int d0 = 0; d0 < 4; ++d0) koff[d0] = (unsigned)(((2 * d0 + hi) ^ ((r32 >> 1) & 7)) << 4);
    ATT_QK(p0, p1, 0);
    if (comp == 1) { LDS_WAIT(); __builtin_amdgcn_s_barrier(); }
    for (int j = 0; j < NT; ++j) {
        if (j + 3 < NT) ATT_DMA_K(j + 3, (j + 3) & 3);
        if (j + 2 < NT) ATT_DMA_V(j + 2, (j + 2) & 3);
        if (j >= 1 && j - 1 < ntw) ATT_PVALL((j - 1) & 3);
        LDS_WAIT(); __builtin_amdgcn_s_barrier(); __builtin_amdgcn_sched_barrier(0);
        if (j < ntw) ATT_SOFTMAX();
        if (j + 1 < ntw) ATT_QK(p0, p1, (j + 1) & 3);
        if (j + 3 < NT) asm volatile("s_waitcnt vmcnt(4)" ::: "memory"); else if (j + 2 < NT) asm volatile("s_waitcnt vmcnt(2)" ::: "memory"); else asm volatile("s_waitcnt vmcnt(0)" ::: "memory");
        LDS_WAIT(); __builtin_amdgcn_s_barrier(); __builtin_amdgcn_sched_barrier(0);
    }
    if (comp == 0) { __builtin_amdgcn_s_barrier(); }
    if (NT - 1 < ntw) ATT_PVALL((NT - 1) & 3);
#undef ATT_SOFTMAX
#undef ATT_FADD
#undef ATT_EXPSUM
#undef ATT_PVALL
#undef ATT_DMA_K
#undef ATT_DMA_V
#undef ATT_QK
#undef ATT_TRR
#undef ATT_VRD
#undef ATT_PV
    __syncthreads();
    { const auto r_ = __builtin_amdgcn_permlane32_swap(__float_as_uint(lsum), __float_as_uint(lsum), false, false); lsum = __uint_as_float(r_[0]) + __uint_as_float(r_[1]); }
    float inv[16];
#pragma unroll
    for (int r = 0; r < 16; ++r) { const int ra = (r & 3) + 8 * (r >> 2);
        const float la = __int_as_float(__builtin_amdgcn_readlane(__float_as_int(lsum), ra)), lb_ = __int_as_float(__builtin_amdgcn_readlane(__float_as_int(lsum), ra + 4));
        inv[r] = __builtin_amdgcn_rcpf(hi ? lb_ : la); }
    f32x4 sg[8];
    { const int c0_ = (lane & 3) * 32;
#pragma unroll
      for (int i = 0; i < 8; ++i) sg[i] = *(const f32x4*)(subg + c0_ + 4 * i); }
    LAS float* X = (LAS float*)lds;
    if (comp == 1) {
#pragma unroll
        for (int cb = 0; cb < 4; ++cb)
#pragma unroll
            for (int r = 0; r < 16; ++r) X[(32 * rg + crow(r, hi)) * XS + cb * 32 + r32] = lam * o[cb][r] * inv[r];
    }
    __syncthreads();
    if (comp == 0) {
#pragma unroll
        for (int cb = 0; cb < 4; ++cb)
#pragma unroll
            for (int r = 0; r < 16; ++r) { const int idx = (32 * rg + crow(r, hi)) * XS + cb * 32 + r32; X[idx] = o[cb][r] * inv[r] - X[idx]; }
    }
    __syncthreads();
    {
        const int row = 16 * wid + (lane >> 2), c0 = (lane & 3) * 32;
        f32x4 dv[8]; float ss = 0.f;
#pragma unroll
        for (int i = 0; i < 8; ++i) { dv[i] = *(const LAS f32x4*)(X + row * XS + c0 + 4 * i); ss += (dv[i].x * dv[i].x + dv[i].y * dv[i].y) + (dv[i].z * dv[i].z + dv[i].w * dv[i].w); }
        ss += __shfl_xor(ss, 1); ss += __shfl_xor(ss, 2);
        const float rstd = oscale / sqrtf(ss * (1.f / 128.f) + EPS);
        float vo[4][8];
#pragma unroll
        for (int i = 0; i < 4; ++i) { const f32x4 g0 = sg[2 * i], g1 = sg[2 * i + 1]; const f32x4 a = dv[2 * i] * g0 * rstd, c = dv[2 * i + 1] * g1 * rstd;
            vo[i][0] = a.x; vo[i][1] = a.y; vo[i][2] = a.z; vo[i][3] = a.w; vo[i][4] = c.x; vo[i][5] = c.y; vo[i][6] = c.z; vo[i][7] = c.w; }
        if (mix8) { unsigned char* op = (unsigned char*)mix + (rowb + t0 + row) * D + h * 128 + c0;
            const v2u w0 = pk8_fp8(vo[0]), w1 = pk8_fp8(vo[1]), w2 = pk8_fp8(vo[2]), w3 = pk8_fp8(vo[3]);
            *(GAS v4u*)op = (v4u){w0.x, w0.y, w1.x, w1.y}; *(GAS v4u*)(op + 16) = (v4u){w2.x, w2.y, w3.x, w3.y}; }
        else { bf16* op = mix + (rowb + t0 + row) * D + h * 128 + c0;
#pragma unroll
            for (int i = 0; i < 4; ++i) *(GAS v4u*)(op + 8 * i) = (v4u){pk2(vo[i][0], vo[i][1]), pk2(vo[i][2], vo[i][3]), pk2(vo[i][4], vo[i][5]), pk2(vo[i][6], vo[i][7])}; }
    }
    __syncthreads();
}
constexpr int HQ_I = 0, HK_I = 8192, HKV_I = 16384, HV_I = 24576, HO_B = 32768, HOB_STRIDE = 64 * 68 * 4, HSC = HO_B + 3 * HOB_STRIDE;
__device__ __forceinline__ float dpp_scan_step(float x, const int ctrl_sel) {
    int t;
    const int xi = __float_as_int(x);
    switch (ctrl_sel) {
        case 0: t = __builtin_amdgcn_update_dpp(0, xi, 0x111, 0xf, 0xf, false); break;
        case 1: t = __builtin_amdgcn_update_dpp(0, xi, 0x112, 0xf, 0xf, false); break;
        case 2: t = __builtin_amdgcn_update_dpp(0, xi, 0x114, 0xf, 0xf, false); break;
        case 3: t = __builtin_amdgcn_update_dpp(0, xi, 0x118, 0xf, 0xf, false); break;
        case 4: t = __builtin_amdgcn_update_dpp(0, xi, 0x142, 0xa, 0xf, false); break;
        default: t = __builtin_amdgcn_update_dpp(0, xi, 0x143, 0xc, 0xf, false); break;
    }
    return x + __int_as_float(t);
}
__device__ __forceinline__ void hgrn_unit(const Args& A, Frame& F, int l, int bh) {
    const int tid = F.tid, lane = F.lane, wid = F.wave, r32 = lane & 31, hi = lane >> 5;
    const int b = bh >> 2, h = bh & 3;
    const bf16* u = (const bf16*)(F.ws + WS_U); bf16* mix = (bf16*)(F.ws + WS_MIX);
    LAS unsigned char* lds = F.lds;
    const size_t row0 = (size_t)b * SEQ;
    const bf16* pq = u + (row0 + lane) * DIN + BQ + h * 64 + 8 * wid;
    const bf16* pf = u + (row0 + lane) * DIN + BF + h * 64 + 8 * wid;
    const bf16* pv = u + (row0 + lane) * DIN + BI + h * 64 + 8 * wid;
    const int et = tid >> 3, ev = (tid & 7) * 8;
    const bf16* pg = u + (row0 + et) * DIN + BG + h * 64 + ev;
    float lbv[8];
    { const float* lbl = (const float*)(F.ws + WS_MISC + MISC_LB) + l * 256 + h * 64 + 8 * wid;
#pragma unroll
      for (int j = 0; j < 8; ++j) lbv[j] = lbl[j]; }
    const f32x4 ng0 = *(const f32x4*)(A.in[12] + l * 64 + ev), ng1 = *(const f32x4*)(A.in[12] + l * 64 + ev + 4);
    f32x16 S;
#pragma unroll
    for (int r = 0; r < 16; ++r) S[r] = 0.f;
    const int ti = (wid >> 1) & 1, vi = wid & 1;
    const unsigned perm_off = ((lane >> 4) & 1) * 32 + (lane & 3) * 8 + (4 * hi + ((lane & 15) >> 2)) * 64;
    v4u rq = *(const GAS v4u*)pq, rf = *(const GAS v4u*)pf, rv = *(const GAS v4u*)pv, rg = *(const GAS v4u*)pg;
    for (int c = 0; c < SEQ / 64; ++c) {
        const unsigned qw[4] = {rq.x, rq.y, rq.z, rq.w}, fw[4] = {rf.x, rf.y, rf.z, rf.w};
        const v4u vraw = rv, graw = rg;
        if (c + 1 < SEQ / 64) { const size_t go = (size_t)(c + 1) * 64 * DIN; rq = *(const GAS v4u*)(pq + go); rf = *(const GAS v4u*)(pf + go); rv = *(const GAS v4u*)(pv + go); rg = *(const GAS v4u*)(pg + go); }
        float qv[8], kv[8], g[8];
#pragma unroll
        for (int j = 0; j < 4; ++j) {
            const float z0 = bflo(qw[j]), z1 = bfhi(qw[j]); qv[2 * j] = z0 * fsigmoid(z0); qv[2 * j + 1] = z1 * fsigmoid(z1);
            const float y0 = bflo(fw[j]), y1 = bfhi(fw[j]);
            const float f0 = lbv[2 * j] + (1.0f - lbv[2 * j]) * fsigmoid(y0), f1 = lbv[2 * j + 1] + (1.0f - lbv[2 * j + 1]) * fsigmoid(y1);
            kv[2 * j] = 1.0f - f0; kv[2 * j + 1] = 1.0f - f1;
            g[2 * j] = __builtin_amdgcn_logf(fmaxf(f0, 1e-30f)); g[2 * j + 1] = __builtin_amdgcn_logf(fmaxf(f1, 1e-30f));
        }
#pragma unroll
        for (int st = 0; st < 6; ++st) {
#pragma unroll
            for (int j = 0; j < 8; ++j) g[j] = dpp_scan_step(g[j], st);
        }
        unsigned qp[4], kp[4];
        float aref[8], alast[8], alr[8];
#pragma unroll
        for (int j = 0; j < 8; ++j) {
            const float gref = __int_as_float(__builtin_amdgcn_readlane(__float_as_int(g[j]), 31)), glast = __int_as_float(__builtin_amdgcn_readlane(__float_as_int(g[j]), 63));
            const float eq = fminf(fmaxf(g[j] - gref, -120.f), 120.f);
            qv[j] *= __builtin_amdgcn_exp2f(eq); kv[j] *= __builtin_amdgcn_exp2f(-eq);
            aref[j] = __builtin_amdgcn_exp2f(fmaxf(gref, -120.f)); alast[j] = __builtin_amdgcn_exp2f(fmaxf(glast, -120.f)); alr[j] = __builtin_amdgcn_exp2f(fmaxf(glast - gref, -120.f));
        }
#pragma unroll
        for (int j = 0; j < 4; ++j) { qp[j] = pk2(qv[2 * j], qv[2 * j + 1]); kp[j] = pk2(kv[2 * j], kv[2 * j + 1]); }
        *(LAS v4u*)(lds + HQ_I + wid * 1024 + lane * 16) = (v4u){qp[0], qp[1], qp[2], qp[3]};
        *(LAS v4u*)(lds + HK_I + wid * 1024 + lane * 16) = (v4u){kp[0], kp[1], kp[2], kp[3]};
        { const unsigned vo = ((wid >> 2) * 4 + (lane >> 4)) * 1024 + (lane & 15) * 64 + ((8 * wid) & 31) * 2;
          *(LAS v4u*)(lds + HKV_I + vo) = (v4u){kp[0], kp[1], kp[2], kp[3]};
          *(LAS v4u*)(lds + HV_I + vo) = vraw; }
        if (lane == 0) { LAS float* sc = (LAS float*)(lds + HSC) + 8 * wid;
#pragma unroll
            for (int j = 0; j < 8; ++j) { sc[j] = aref[j]; sc[64 + j] = alast[j]; sc[128 + j] = alr[j]; } }
        asm volatile("s_waitcnt lgkmcnt(0)" ::: "memory"); __builtin_amdgcn_s_barrier(); asm volatile("" ::: "memory");
        if (wid < 4) {
            bf16x8 qb[4], ka[4], kb[4];
#pragma unroll
            for (int ks = 0; ks < 4; ++ks) { qb[ks] = *(const LAS bf16x8*)(lds + HQ_I + (2 * ks + hi) * 1024 + (32 * ti + r32) * 16); ka[ks] = *(const LAS bf16x8*)(lds + HK_I + (2 * ks + hi) * 1024 + r32 * 16);
                kb[ks] = *(const LAS bf16x8*)(lds + HK_I + (2 * ks + hi) * 1024 + (32 + r32) * 16); }
            s16x4 vl[4], vh[4];
#pragma unroll
            for (int k2 = 0; k2 < 4; ++k2) { vl[k2] = vtr(lds + HV_I + (vi * 4 + k2) * 1024 + perm_off); vh[k2] = vtr(lds + HV_I + (vi * 4 + k2) * 1024 + perm_off + 512); }
            f32x16 P0, P1, acc;
#pragma unroll
            for (int r = 0; r < 16; ++r) { P0[r] = 0.f; P1[r] = 0.f; acc[r] = 0.f; }
#pragma unroll
            for (int ks = 0; ks < 4; ++ks) P0 = __builtin_amdgcn_mfma_f32_32x32x16_bf16(ka[ks], qb[ks], P0, 0, 0, 0);
            if (ti == 1) {
#pragma unroll
                for (int ks = 0; ks < 4; ++ks) P1 = __builtin_amdgcn_mfma_f32_32x32x16_bf16(kb[ks], qb[ks], P1, 0, 0, 0);
#pragma unroll
                for (int r = 0; r < 16; ++r) if (crow(r, hi) > r32) P1[r] = 0.f;
            } else {
#pragma unroll
                for (int r = 0; r < 16; ++r) if (crow(r, hi) > r32) P0[r] = 0.f;
            }
#pragma unroll
            for (int k2 = 0; k2 < 2; ++k2) {
                const bf16x8 vb = {vl[k2][0], vl[k2][1], vl[k2][2], vl[k2][3], vh[k2][0], vh[k2][1], vh[k2][2], vh[k2][3]};
                const v4u pw = {pk2(P0[8 * k2], P0[8 * k2 + 1]), pk2(P0[8 * k2 + 2], P0[8 * k2 + 3]), pk2(P0[8 * k2 + 4], P0[8 * k2 + 5]), pk2(P0[8 * k2 + 6], P0[8 * k2 + 7])};
                acc = __builtin_amdgcn_mfma_f32_32x32x16_bf16(__builtin_bit_cast(bf16x8, pw), vb, acc, 0, 0, 0);
            }
            if (ti == 1) {
#pragma unroll
                for (int k2 = 0; k2 < 2; ++k2) {
                    const bf16x8 vb = {vl[2 + k2][0], vl[2 + k2][1], vl[2 + k2][2], vl[2 + k2][3], vh[2 + k2][0], vh[2 + k2][1], vh[2 + k2][2], vh[2 + k2][3]};
                    const v4u pw = {pk2(P1[8 * k2], P1[8 * k2 + 1]), pk2(P1[8 * k2 + 2], P1[8 * k2 + 3]), pk2(P1[8 * k2 + 4], P1[8 * k2 + 5]), pk2(P1[8 * k2 + 6], P1[8 * k2 + 7])};
                    acc = __builtin_amdgcn_mfma_f32_32x32x16_bf16(__builtin_bit_cast(bf16x8, pw), vb, acc, 0, 0, 0);
                }
            }
            LAS float* OB = (LAS float*)(lds + HO_B);
#pragma unroll
            for (int r = 0; r < 16; ++r) OB[(32 * ti + crow(r, hi)) * 68 + 32 * vi + r32] = acc[r];
        } else {
            const LAS float* sc = (const LAS float*)(lds + HSC) + 32 * ti;
            float ar[16];
#pragma unroll
            for (int r = 0; r < 16; ++r) ar[r] = sc[crow(r, hi)];
            v2u qa[2][2][2];
#pragma unroll
            for (int tt = 0; tt < 2; ++tt)
#pragma unroll
                for (int sx = 0; sx < 2; ++sx) { qa[tt][sx][0] = *(const LAS v2u*)(lds + HQ_I + (4 * ti + 2 * sx) * 1024 + (32 * tt + r32) * 16 + 8 * hi); qa[tt][sx][1] = *(const LAS v2u*)(lds + HQ_I + (4 * ti + 2 * sx + 1) * 1024 + (32 * tt + r32) * 16 + 8 * hi); }
            s16x4 kl[4], kh[4], vl[4], vh[4];
#pragma unroll
            for (int ks = 0; ks < 4; ++ks) { kl[ks] = vtr(lds + HKV_I + (ti * 4 + ks) * 1024 + perm_off); kh[ks] = vtr(lds + HKV_I + (ti * 4 + ks) * 1024 + perm_off + 512);
                vl[ks] = vtr(lds + HV_I + (vi * 4 + ks) * 1024 + perm_off); vh[ks] = vtr(lds + HV_I + (vi * 4 + ks) * 1024 + perm_off + 512); }
            v4u sb[2];
#pragma unroll
            for (int sx = 0; sx < 2; ++sx) sb[sx] = (v4u){pk2(S[8 * sx] * ar[8 * sx], S[8 * sx + 1] * ar[8 * sx + 1]), pk2(S[8 * sx + 2] * ar[8 * sx + 2], S[8 * sx + 3] * ar[8 * sx + 3]),
                                                          pk2(S[8 * sx + 4] * ar[8 * sx + 4], S[8 * sx + 5] * ar[8 * sx + 5]), pk2(S[8 * sx + 6] * ar[8 * sx + 6], S[8 * sx + 7] * ar[8 * sx + 7])};
            f32x16 o0, o1, acc;
#pragma unroll
            for (int r = 0; r < 16; ++r) { o0[r] = 0.f; o1[r] = 0.f; acc[r] = 0.f; }
#pragma unroll
            for (int sx = 0; sx < 2; ++sx) {
                const v4u a0 = {qa[0][sx][0].x, qa[0][sx][0].y, qa[0][sx][1].x, qa[0][sx][1].y}, a1 = {qa[1][sx][0].x, qa[1][sx][0].y, qa[1][sx][1].x, qa[1][sx][1].y};
                o0 = __builtin_amdgcn_mfma_f32_32x32x16_bf16(__builtin_bit_cast(bf16x8, a0), __builtin_bit_cast(bf16x8, sb[sx]), o0, 0, 0, 0);
                o1 = __builtin_amdgcn_mfma_f32_32x32x16_bf16(__builtin_bit_cast(bf16x8, a1), __builtin_bit_cast(bf16x8, sb[sx]), o1, 0, 0, 0);
            }
#pragma unroll
            for (int ks = 0; ks < 4; ++ks) {
                const bf16x8 ka = {kl[ks][0], kl[ks][1], kl[ks][2], kl[ks][3], kh[ks][0], kh[ks][1], kh[ks][2], kh[ks][3]}, vb = {vl[ks][0], vl[ks][1], vl[ks][2], vl[ks][3], vh[ks][0], vh[ks][1], vh[ks][2], vh[ks][3]};
                acc = __builtin_amdgcn_mfma_f32_32x32x16_bf16(ka, vb, acc, 0, 0, 0);
            }
            LAS float* OB = (LAS float*)(lds + HO_B + (1 + ti) * HOB_STRIDE);
#pragma unroll
            for (int r = 0; r < 16; ++r) { OB[crow(r, hi) * 68 + 32 * vi + r32] = o0[r]; OB[(32 + crow(r, hi)) * 68 + 32 * vi + r32] = o1[r]; }
#pragma unroll
            for (int r = 0; r < 16; ++r) { const int dl = crow(r, hi); S[r] = sc[64 + dl] * S[r] + sc[128 + dl] * acc[r]; }
        }
        asm volatile("s_waitcnt lgkmcnt(0)" ::: "memory"); __builtin_amdgcn_s_barrier(); asm volatile("" ::: "memory");
        {
            const LAS float* OB = (const LAS float*)(lds + HO_B) + et * 68 + ev;
            f32x4 o0 = *(const LAS f32x4*)OB, o1 = *(const LAS f32x4*)(OB + 4);
            o0 += *(const LAS f32x4*)(OB + HOB_STRIDE / 4); o1 += *(const LAS f32x4*)(OB + HOB_STRIDE / 4 + 4);
            o0 += *(const LAS f32x4*)(OB + 2 * (HOB_STRIDE / 4)); o1 += *(const LAS f32x4*)(OB + 2 * (HOB_STRIDE / 4) + 4);
            float ss = (o0.x * o0.x + o0.y * o0.y) + (o0.z * o0.z + o0.w * o0.w) + (o1.x * o1.x + o1.y * o1.y) + (o1.z * o1.z + o1.w * o1.w);
            ss += __shfl_xor(ss, 1); ss += __shfl_xor(ss, 2); ss += __shfl_xor(ss, 4);
            const float rstd = 1.0f / sqrtf(ss * (1.f / 64.f) + EPS);
            const float z0 = bflo(graw.x), z1 = bfhi(graw.x), z2 = bflo(graw.y), z3 = bfhi(graw.y), z4 = bflo(graw.z), z5 = bfhi(graw.z), z6 = bflo(graw.w), z7 = bfhi(graw.w);
            const float hv[8] = {o0.x * rstd * ng0.x * z0 * fsigmoid(z0), o0.y * rstd * ng0.y * z1 * fsigmoid(z1), o0.z * rstd * ng0.z * z2 * fsigmoid(z2), o0.w * rstd * ng0.w * z3 * fsigmoid(z3),
                                 o1.x * rstd * ng1.x * z4 * fsigmoid(z4), o1.y * rstd * ng1.y * z5 * fsigmoid(z5), o1.z * rstd * ng1.z * z6 * fsigmoid(z6), o1.w * rstd * ng1.w * z7 * fsigmoid(z7)};
            if (l == 0) *(GAS v4u*)(mix + (row0 + 64 * c + et) * D + 512 + h * 64 + ev) = (v4u){pk2(hv[0], hv[1]), pk2(hv[2], hv[3]), pk2(hv[4], hv[5]), pk2(hv[6], hv[7])};
            else *(GAS v2u*)((unsigned char*)mix + (row0 + 64 * c + et) * D + 512 + h * 64 + ev) = pk8_fp8(hv);
        }
    }
    __syncthreads();
}
__device__ __forceinline__ void mixer_phase(const Args& A, Frame& F, int l) {
    const bf16* u = (const bf16*)(F.ws + WS_U); bf16* mix = (bf16*)(F.ws + WS_MIX);
    const float lam = ((const float*)(F.ws + WS_MISC + MISC_LAM))[l];
    const float lam_init = 0.8f - 0.6f * expf(-0.3f * (float)l);
    volatile LAS int* slot = (volatile LAS int*)(F.lds + MISC_OFF + 64);
    constexpr int N_DEF = (ITEMS_PER_LAYER - I_WIN) + ITEMS_PER_LAYER, N_DEFQ = (N_DEF / 64 + 8) / 8;
    const int nq = (l == 0) ? 304 + N_DEFQ : 304;
    static_assert(304 + N_DEFQ <= 512 && N_DEFQ * 8 * 64 >= N_DEF, "queue index space");
    const int xq0 = (F.vcu >> 5) & 7; int xo = 0;
    for (;;) {
        __syncthreads();
        if (F.tid == 0) { int got = -1;
            while (xo < 8) { const int x = (xq0 + xo) & 7; const int i = (int)__hip_atomic_fetch_add((unsigned*)(F.ctl + CW_Q + 1024 * l + 64 * x), 1u, RLX_AGENT);
                if (i < nq) { got = x * 512 + i; break; } ++xo; }
            *slot = got; }
        __syncthreads();
        const int qi = __builtin_amdgcn_readfirstlane(*slot);
        if (qi < 0) break;
        xo = __builtin_amdgcn_readfirstlane(xo);
        const int qx = qi >> 9, qp_ = qi & 511;
        int qr_ = qp_;
        if (l == 0) { const int k3 = qp_ / 3; const bool isw = (qp_ - 3 * k3 == 2) && (k3 < N_DEFQ); const int nw = ((qp_ + 1) / 3 < N_DEFQ) ? (qp_ + 1) / 3 : N_DEFQ; qr_ = isw ? (304 + k3) : (qp_ - nw); }
        const int idx = (qr_ < 16) ? (qx * 16 + qr_) : 128;
        const int a_bh = qx * 16 + ((qr_ - 16) >> 4), a_rb = 15 - ((qr_ - 16) & 15);
        { int t_ = threadIdx.x; asm volatile("" : "+v"(t_)); F.tid = t_; F.lane = t_ & 63; F.wave = __builtin_amdgcn_readfirstlane(t_ >> 6); }
#if PROBE
        const unsigned long long tu0 = __builtin_amdgcn_s_memrealtime();
#endif
        if (idx < 128) hgrn_unit(A, F, l, idx);
        else if (qr_ >= 304) { const int it0 = (qx * N_DEFQ + (qr_ - 304)) * 64 + F.wave * 8; LAS float* scr = (LAS float*)(F.lds + RING_OFF + F.wave * 16384);
            WItem d0, d1; f32x4 wa[8], wb[8]; float ka[8], kb_[8];
            witem_desc(A, F.ws, it0, d0); wt_load(d0.W, d0.N, d0.k0, d0.n0, d0.ks, F.lane, wa, ka);
#pragma unroll
            for (int i = 0; i < 8; i += 2) {
                witem_desc(A, F.ws, it0 + i + 1, d1); wt_load(d1.W, d1.N, d1.k0, d1.n0, d1.ks, F.lane, wb, kb_);
                witem_finish(d0, wa, ka, scr, F.lane);
                if (i + 2 < 8) { witem_desc(A, F.ws, it0 + i + 2, d0); wt_load(d0.W, d0.N, d0.k0, d0.n0, d0.ks, F.lane, wa, ka); }
                witem_finish(d1, wb, kb_, scr, F.lane);
            } }
        else if (qr_ >= 272) conv_unit(A, F, l, qx * 32 + (qr_ - 272));
        else attn_unit(F, u, mix, a_bh >> 2, a_bh & 3, a_rb, lam, 1.0f - lam_init, A.in[10] + l * 128, l != 0);
#if PROBE
        if (threadIdx.x == 0) atomicAdd((unsigned long long*)(F.ctl + 12288) + (idx < 128 ? 0 : 8), (unsigned long long)(__builtin_amdgcn_s_memrealtime() - tu0));
#endif
    }
}

constexpr int RT_OFF = LDSCTL_OFF + 4096;
__device__ __forceinline__ void route_phase(const Args& A, Frame& F, int l) {
    const int lane = F.lane, tid = F.tid, wid = F.wave, r32 = lane & 31, hi = lane >> 5;
    const bf16* X = (const bf16*)(F.ws + WS_XN); unsigned char* X8 = F.ws + WS_X8;
    const bf16* WrB = (const bf16*)(F.ws + WS_MISC + MISC_WRB) + (size_t)l * 16 * 8192;
    int* tokpos = (int*)(F.ws + WS_MISC + MISC_TOKPOS); float* tokgate = (float*)(F.ws + WS_MISC + MISC_TOKGATE);
    LAS int* lcnt = (LAS int*)(F.lds + RT_OFF); LAS int* lbase = lcnt + 32; LAS int* asg = lcnt + 64; LAS float* tot = (LAS float*)(F.lds + RT_OFF + 2304) + wid * 32;
    LAS unsigned char* wst = F.lds;
    LAS unsigned char* stg = F.lds + 32768 + wid * 4096;
    if (tid < 32) lcnt[tid] = 0;
    const int tb = F.vcu * 256 + wid * 32;
    f32x16 acc0, acc1; float ssq[4];
#pragma unroll
    for (int r = 0; r < 16; ++r) { acc0[r] = 0.f; acc1[r] = 0.f; }
#pragma unroll
    for (int r = 0; r < 4; ++r) ssq[r] = 0.f;
#define RT_DMA(kc, st) do { _Pragma("unroll") for (int q_ = 0; q_ < 2; ++q_) \
        __builtin_amdgcn_global_load_lds((const unsigned*)(WrB + (size_t)(kc) * 8192 + (2 * wid + q_) * 512 + lane * 8), (LAS unsigned*)(wst + (st) * 16384 + (2 * wid + q_) * 1024), 16, 0, 0); } while (0)
    const bf16* xp = X + (size_t)(tb + (lane >> 3)) * D + (lane & 7) * 8;
    v4u xv[4];
    RT_DMA(0, 0);
#pragma unroll
    for (int i = 0; i < 4; ++i) xv[i] = *(const GAS v4u*)(xp + (size_t)(8 * i) * D);
    VM_WAIT(); __syncthreads();
    unsigned boff[4];
#pragma unroll
    for (int ks = 0; ks < 4; ++ks) boff[ks] = (unsigned)(r32 * 128 + (((2 * ks + hi) ^ ((r32 >> 1) & 7)) << 4));
    for (int kc = 0; kc < 16; ++kc) {
        const int st = kc & 1;
        if (kc + 1 < 16) RT_DMA(kc + 1, st ^ 1);
#pragma unroll
        for (int i = 0; i < 4; ++i) {
            const v4u x = xv[i];
            const float a0 = bflo(x.x), a1 = bfhi(x.x), a2 = bflo(x.y), a3 = bfhi(x.y), a4 = bflo(x.z), a5 = bfhi(x.z), a6 = bflo(x.w), a7 = bfhi(x.w);
            ssq[i] += ((a0 * a0 + a1 * a1) + (a2 * a2 + a3 * a3)) + ((a4 * a4 + a5 * a5) + (a6 * a6 + a7 * a7));
            const int tk = (lane >> 3) + 8 * i;
            *(LAS v4u*)(stg + tk * 128 + (((lane & 7) ^ ((tk >> 1) & 7)) << 4)) = x;
            { int w0 = 0, w1 = 0;
              w0 = __builtin_amdgcn_cvt_pk_fp8_f32(fp8c(a0), fp8c(a1), w0, false); w0 = __builtin_amdgcn_cvt_pk_fp8_f32(fp8c(a2), fp8c(a3), w0, true);
              w1 = __builtin_amdgcn_cvt_pk_fp8_f32(fp8c(a4), fp8c(a5), w1, false); w1 = __builtin_amdgcn_cvt_pk_fp8_f32(fp8c(a6), fp8c(a7), w1, true);
              *(GAS v2u*)(X8 + (size_t)(tb + tk) * D + kc * 64 + (lane & 7) * 8) = (v2u){(unsigned)w0, (unsigned)w1}; }
        }
        if (kc + 1 < 16) {
#pragma unroll
            for (int i = 0; i < 4; ++i) xv[i] = *(const GAS v4u*)(xp + (size_t)(8 * i) * D + (kc + 1) * 64);
        }
        const LAS unsigned char* wb = wst + st * 16384 + r32 * 16;
#pragma unroll
        for (int ks = 0; ks < 4; ++ks) {
            const bf16x8 bx = *(const LAS bf16x8*)(stg + boff[ks]);
            const bf16x8 aH0 = *(const LAS bf16x8*)(wb + (0 * 8 + 2 * ks + hi) * 512), aL0 = *(const LAS bf16x8*)(wb + (1 * 8 + 2 * ks + hi) * 512);
            const bf16x8 aH1 = *(const LAS bf16x8*)(wb + (2 * 8 + 2 * ks + hi) * 512), aL1 = *(const LAS bf16x8*)(wb + (3 * 8 + 2 * ks + hi) * 512);
            acc0 = __builtin_amdgcn_mfma_f32_32x32x16_bf16(aH0, bx, acc0, 0, 0, 0); acc1 = __builtin_amdgcn_mfma_f32_32x32x16_bf16(aH1, bx, acc1, 0, 0, 0);
            acc0 = __builtin_amdgcn_mfma_f32_32x32x16_bf16(aL0, bx, acc0, 0, 0, 0); acc1 = __builtin_amdgcn_mfma_f32_32x32x16_bf16(aL1, bx, acc1, 0, 0, 0);
        }
        VM_WAIT(); __syncthreads();
    }
#undef RT_DMA
#pragma unroll
    for (int i = 0; i < 4; ++i) { float sv = ssq[i]; sv += __shfl_xor(sv, 1); sv += __shfl_xor(sv, 2); sv += __shfl_xor(sv, 4); if ((lane & 7) == 0) tot[(lane >> 3) + 8 * i] = sv; }
    LDS_WAIT(); asm volatile("" ::: "memory");
    const float rs = 1.0f / sqrtf(tot[r32] * (1.f / D) + EPS);
    const int m = tb + r32;
    LAS float* rsl = (LAS float*)(F.lds + RT_OFF + 3328);
    if (hi == 0) rsl[wid * 32 + r32] = rs;
    float gl[4];
#pragma unroll
    for (int j = 0; j < 4; ++j) { const float t = acc1[j] * rs + A.in[17][l * 4 + j]; gl[j] = __shfl(t, r32); }
    int g = 0; float gm = gl[0];
#pragma unroll
    for (int j = 1; j < 4; ++j) if (gl[j] > gm) { gm = gl[j]; g = j; }
    float den = 0.f;
#pragma unroll
    for (int j = 0; j < 4; ++j) den += expf(gl[j] - gm);
    const float pg = 1.0f / den;
    float own[4];
#pragma unroll
    for (int j = 0; j < 4; ++j) { const float a0 = acc0[j], a1 = acc0[4 + j], a2 = acc0[8 + j], a3 = acc0[12 + j];
        const float a = (g == 0) ? a0 : (g == 1) ? a1 : (g == 2) ? a2 : a3;
        own[j] = a * rs + A.in[19][l * 32 + 8 * g + 4 * hi + j]; }
    float ev[8];
#pragma unroll
    for (int j = 0; j < 4; ++j) { const float oth = __shfl_xor(own[j], 32); ev[j] = hi ? oth : own[j]; ev[4 + j] = hi ? own[j] : oth; }
    int i1 = 0; float v1 = ev[0];
#pragma unroll
    for (int j = 1; j < 8; ++j) if (ev[j] > v1) { v1 = ev[j]; i1 = j; }
    int i2 = -1; float v2 = -3.0e38f;
#pragma unroll
    for (int j = 0; j < 8; ++j) if (j != i1 && ev[j] > v2) { v2 = ev[j]; i2 = j; }
    const float e21 = expf(v2 - v1), w1 = 1.0f / (1.0f + e21), w2 = e21 * w1;
    if (hi == 0) {
        const int e1 = 8 * g + i1, e2 = 8 * g + i2;
        const int lp1 = atomicAdd((int*)&lcnt[e1], 1), lp2 = atomicAdd((int*)&lcnt[e2], 1);
        const int tl_ = wid * 32 + r32;
        asg[tl_ * 2] = (e1 << 16) | lp1; asg[tl_ * 2 + 1] = (e2 << 16) | lp2;
        tokgate[(size_t)m * 2] = pg * w1; tokgate[(size_t)m * 2 + 1] = pg * w2;
    }
    __syncthreads();
    if (tid < 32) lbase[tid] = (int)__hip_atomic_fetch_add((unsigned*)(F.ctl + CW_CNT + l * 32 + tid), (unsigned)lcnt[tid], RLX_AGENT);
    __syncthreads();
    { const int a = asg[tid]; const int e = a >> 16, lp = a & 0xffff, pos = lbase[e] + lp; tokpos[(size_t)(F.vcu * 256) * 2 + tid] = (e << 16) | pos;
      ((int*)(F.ws + WS_LIST))[(size_t)e * 65536 + pos] = F.vcu * 256 + (tid >> 1); ((float*)(F.ws + WS_LRS))[(size_t)e * 65536 + pos] = rsl[tid >> 1]; }
    __syncthreads();
}
__device__ __forceinline__ void moe_tables(Frame& F, int l) {
    LAS int* ts = (LAS int*)(F.lds + TAB_OFF); LAS int* ut = (LAS int*)(F.lds + TAB_OFF + 256);
    __syncthreads();
    if (F.tid < 64) { const int e = F.tid & 31;
        const int nt_ = ((int)__hip_atomic_load((unsigned*)(F.ctl + CW_CNT + l * 32 + e), RLX_AGENT) + 255) >> 8;
        int inc = nt_;
#pragma unroll
        for (int off = 1; off < 32; off <<= 1) { const int y = __shfl_up(inc, off, 32); if (e >= off) inc += y; }
        if (F.tid < 32) { ts[e] = inc - nt_; if (e == 31) ts[32] = inc; } }
    __syncthreads();
    if (F.tid < 16) { const int L = F.tid * F.G + F.vcu; int p = -1, rel = 0, nv = 0;
        if (L < 4 * ts[32]) { const int rt = L >> 2; int e = 0; for (int j = 1; j < 32; ++j) e += (ts[j] <= rt) ? 1 : 0; p = (e << 24) | L; rel = rt - ts[e];
            const int cnt = (int)__hip_atomic_load((unsigned*)(F.ctl + CW_CNT + l * 32 + e), RLX_AGENT) - rel * 256; nv = cnt < 256 ? cnt : 256; }
        ut[3 * F.tid] = p; ut[3 * F.tid + 1] = rel; ut[3 * F.tid + 2] = nv; }
    __syncthreads();
}
__device__ __forceinline__ void combine_phase(const Args& A, Frame& F, int l, const bool have_tables) {
    const int gw = F.vcu * 8 + F.wave, NGW = F.G * 8, lane = F.lane;
    bf16* X = (bf16*)(F.ws + WS_XN); const unsigned char* Y = F.ws + WS_XG; float* out = F.out; float* rsm = (float*)(F.ws + WS_MISC + MISC_RSTDMIX);
    const int* tokpos = (const int*)(F.ws + WS_MISC + MISC_TOKPOS); const float* tokgate = (const float*)(F.ws + WS_MISC + MISC_TOKGATE);
    if (!have_tables) moe_tables(F, l);
    const LAS int* ts = (const LAS int*)(F.lds + TAB_OFF);
    const bool last = (l + 1 == DEPTH);
#define CB_ROUTE(m_, tp0_, tp1_, g0_, g1_) do { const size_t mn_ = (size_t)(m_) * 2; tp0_ = tokpos[mn_]; tp1_ = tokpos[mn_ + 1]; g0_ = 0.125f * tokgate[mn_]; g1_ = 0.125f * tokgate[mn_ + 1]; } while (0)
#define CB_LOAD(m_, tp0_, tp1_, xa_, ya_, yb_) do { const int s0_ = ts[(tp0_) >> 16] * 256 + ((tp0_) & 0xffff), s1_ = ts[(tp1_) >> 16] * 256 + ((tp1_) & 0xffff); \
        const GAS v4u* xr_ = (const GAS v4u*)(X + (size_t)(m_) * D) + 2 * lane; xa_[0] = xr_[0]; xa_[1] = xr_[1]; \
        ya_ = *((const GAS v4u*)(Y + (size_t)s0_ * D) + lane); yb_ = *((const GAS v4u*)(Y + (size_t)s1_ * D) + lane); } while (0)
    int tpa0 = 0, tpa1 = 0, tpb0 = 0, tpb1 = 0; float ga0 = 0.f, ga1 = 0.f, gb0 = 0.f, gb1 = 0.f;
    v4u xn[2], yna, ynb;
    CB_ROUTE(gw, tpa0, tpa1, ga0, ga1);
    if (gw + NGW < M) CB_ROUTE(gw + NGW, tpb0, tpb1, gb0, gb1);
    CB_LOAD(gw, tpa0, tpa1, xn, yna, ynb);
    for (int m = gw; m < M; m += NGW) {
        const v4u xa0 = xn[0], xa1 = xn[1], ya = yna, yb = ynb;
        const float g0 = ga0, g1 = ga1;
        if (m + NGW < M) {
            tpa0 = tpb0; tpa1 = tpb1; ga0 = gb0; ga1 = gb1;
            if (m + 2 * NGW < M) CB_ROUTE(m + 2 * NGW, tpb0, tpb1, gb0, gb1);
            CB_LOAD(m + NGW, tpa0, tpa1, xn, yna, ynb);
        }
        const unsigned xw[8] = {xa0.x, xa0.y, xa0.z, xa0.w, xa1.x, xa1.y, xa1.z, xa1.w}, aw[4] = {ya.x, ya.y, ya.z, ya.w}, bw[4] = {yb.x, yb.y, yb.z, yb.w};
        float v[16]; float s = 0.f;
#pragma unroll
        for (int q = 0; q < 4; ++q) {
            const f32x2 a0 = __builtin_amdgcn_cvt_pk_f32_fp8((int)aw[q], false), a1 = __builtin_amdgcn_cvt_pk_f32_fp8((int)aw[q], true);
            const f32x2 b0 = __builtin_amdgcn_cvt_pk_f32_fp8((int)bw[q], false), b1 = __builtin_amdgcn_cvt_pk_f32_fp8((int)bw[q], true);
            v[4 * q]     = bflo(xw[2 * q])     + g0 * a0[0] + g1 * b0[0]; v[4 * q + 1] = bfhi(xw[2 * q])     + g0 * a0[1] + g1 * b0[1];
            v[4 * q + 2] = bflo(xw[2 * q + 1]) + g0 * a1[0] + g1 * b1[0]; v[4 * q + 3] = bfhi(xw[2 * q + 1]) + g0 * a1[1] + g1 * b1[1]; }
        if (last) { GAS f32x4* op = (GAS f32x4*)(out + (size_t)m * D + 16 * lane);
#pragma unroll
            for (int q = 0; q < 4; ++q) op[q] = (f32x4){v[4 * q], v[4 * q + 1], v[4 * q + 2], v[4 * q + 3]}; }
        else { GAS v4u* xp = (GAS v4u*)(X + (size_t)m * D) + 2 * lane;
            xp[0] = (v4u){pk2(v[0], v[1]), pk2(v[2], v[3]), pk2(v[4], v[5]), pk2(v[6], v[7])}; xp[1] = (v4u){pk2(v[8], v[9]), pk2(v[10], v[11]), pk2(v[12], v[13]), pk2(v[14], v[15])};
#pragma unroll
            for (int q = 0; q < 16; ++q) s += v[q] * v[q];
            const float tot = wave_sum(s); const float rstd = 1.0f / sqrtf(tot * (1.f / D) + EPS); if (lane == 0) rsm[m] = rstd;
            { unsigned w8[4];
#pragma unroll
              for (int q = 0; q < 4; ++q) { int t = 0; t = __builtin_amdgcn_cvt_pk_fp8_f32(fp8c(v[4 * q] * rstd), fp8c(v[4 * q + 1] * rstd), t, false); t = __builtin_amdgcn_cvt_pk_fp8_f32(fp8c(v[4 * q + 2] * rstd), fp8c(v[4 * q + 3] * rstd), t, true); w8[q] = (unsigned)t; }
              *((GAS v4u*)(F.ws + WS_X8B + (size_t)m * D) + lane) = (v4u){w8[0], w8[1], w8[2], w8[3]}; } }
    }
#undef CB_ROUTE
#undef CB_LOAD
}

constexpr int PH_PER_LAYER = 7, N_PHASES = 1 + DEPTH * PH_PER_LAYER;
__global__ void __launch_bounds__(512, 2) mk_fwd(Args args) {
    extern __shared__ __attribute__((aligned(16))) unsigned char lds[];
    Frame F;
    F.lds = (LAS unsigned char*)lds;
    F.MISC = (volatile LAS unsigned*)(F.lds + MISC_OFF);
    F.tid = threadIdx.x; F.lane = F.tid & 63; F.wave = __builtin_amdgcn_readfirstlane(F.tid >> 6);
    F.G = gridDim.x; { const int bx = blockIdx.x; F.vcu = (F.G % 8 == 0) ? (bx % 8) * (F.G / 8) + bx / 8 : bx; }
    F.ws = args.ws; F.out = args.out; F.ctl = (gu32*)(args.ws + WS_CTL);
    for (int u = F.tid; u < (LDS_BYTES - LDSCTL_OFF) / 4; u += 512) ((LAS unsigned*)(F.lds + LDSCTL_OFF))[u] = 0u;
    __syncthreads();
    const int lo = args.ph_lo, hi = args.ph_hi;
    const bool multi = (hi - lo) > 1;
    XcdBarrier bar; bar.bar = (unsigned*)(F.ctl + CW_BAR); bar.x = 0; bar.st = nullptr;
    if (multi) bar = xcd_barrier_post((unsigned*)(F.ctl + CW_BAR), F.MISC + 8);
#ifndef PHSEL
#define PHSEL(j) true
#endif
#define IN(k) (lo <= (k) && (k) < hi)
#define ENTER() do { int t_ = threadIdx.x; asm volatile("" : "+v"(t_)); F.tid = t_; F.lane = t_ & 63; F.wave = __builtin_amdgcn_readfirstlane(t_ >> 6); \
        { int b_ = blockIdx.x; asm volatile("" : "+s"(b_)); F.bx = b_; F.vcu = (F.G % 8 == 0) ? (b_ % 8) * (F.G / 8) + b_ / 8 : b_; } \
        unsigned char* w_ = args.ws; asm volatile("" : "+s"(w_)); F.ws = w_; ws = w_; F.ctl = (gu32*)(w_ + WS_CTL); float* o_ = args.out; asm volatile("" : "+s"(o_)); F.out = o_; } while (0)
#if PROBE
#define STAMP(k) do { if (F.tid == 0) ((volatile LAS unsigned long long*)(F.lds + LDSCTL_OFF + 2048))[(k)] = __builtin_amdgcn_s_memrealtime(); } while (0)
#else
#define STAMP(k) do {} while (0)
#endif
#define SEAM(k) do { if (IN(k) && IN((k) + 1)) xcd_barrier(bar); STAMP((k) + 1); } while (0)
    unsigned char* ws = args.ws;
    STAMP(0);
    if (PHSEL(100) && IN(0)) { ENTER(); p0_prologue(args, F); SEAM(0); }
    for (int l = 0; l < DEPTH; ++l) {
        const int pb = 1 + l * PH_PER_LAYER;
        if (PHSEL(0) && IN(pb + 0)) {
            ENTER();
            const float asc_ = (l == 0) ? 1.0f : 0.03125f;
            if (l == 0) {
                pg8::EpiInProj16T<false> E{(bf16*)(ws + WS_U), (const float*)(ws + WS_MISC + MISC_RSTDMIX), args.in[4] + l * 64, args.in[5] + l * 64, (const float*)(ws + WS_MISC + MISC_ROPE), asc_};
                pg8::DenseOrder S; S.init(ws + WS_XN, ws + WS_WIN, M, DIN, D, F.G, F.bx);
                pg8::gemm_phase<pg8::EpiInProj16T<false>, pg8::DenseOrder, true, false, 127, 127, true>(F.lds + RING_OFF, D, S, E, F.tid);
            } else {
                int kk = D / 2; asm volatile("" : "+s"(kk));
                pg8::EpiInProj16T<true> E{(bf16*)(ws + WS_U), nullptr, args.in[4] + l * 64, args.in[5] + l * 64, (const float*)(ws + WS_MISC + MISC_ROPE), asc_};
                pg8::DenseOrder S; S.init(ws + WS_X8B, ws + WS_WIN + (size_t)DIN * D * 2, M, DIN, kk, F.G, F.bx);
                pg8::gemm_phase<pg8::EpiInProj16T<true>, pg8::DenseOrder, true, true, 127, 122, true>(F.lds + RING_OFF, kk, S, E, F.tid);
            }
            SEAM(pb + 0);
        }
        if (PHSEL(1) && IN(pb + 1)) { ENTER(); mixer_phase(args, F, l); SEAM(pb + 1); }
        if (PHSEL(2) && IN(pb + 2)) {
            ENTER();
            pg8::EpiResBf16 E{(bf16*)(ws + WS_XN), (l == 0) ? 1.0f : 0.0078125f};
            if (l == 0) {
                pg8::DenseOrder S; S.init(ws + WS_MIX, ws + WS_WOUT, M, D, D, F.G, F.bx);
                pg8::gemm_phase<pg8::EpiResBf16, pg8::DenseOrder, true, false, 127, 127, true>(F.lds + RING_OFF, D, S, E, F.tid);
            } else {
                int kk = D / 2; asm volatile("" : "+s"(kk));
                pg8::DenseOrder S; S.init(ws + WS_MIX, ws + WS_WOUT + 2 * MiB, M, D, kk, F.G, F.bx);
                pg8::gemm_phase<pg8::EpiResBf16, pg8::DenseOrder, true, true, 125, 122, true>(F.lds + RING_OFF, kk, S, E, F.tid);
            }
            SEAM(pb + 2);
        }
        if (PHSEL(3) && IN(pb + 3)) { ENTER(); route_phase(args, F, l); SEAM(pb + 3); }
        if (PHSEL(4) && IN(pb + 4)) {
            ENTER();
            moe_tables(F, l);
            pg8::MoeOrder<true> S{(const char*)(ws + WS_X8), (const char*)(ws + WS_WGU + (size_t)l * 32 * D * D), D / 2, (size_t)D * D, (unsigned)(uintptr_t)(F.lds + TAB_OFF + 256), 128, (const int*)(ws + WS_LIST), (const float*)(ws + WS_LRS)};
            pg8::EpiSwiGLU8 E{ws + WS_ACT, 0.03125f};
            int kk = D / 2; asm volatile("" : "+s"(kk));
            pg8::gemm_phase<pg8::EpiSwiGLU8, pg8::MoeOrder<true>, true, true, 127, 122, false>(F.lds + RING_OFF, kk, S, E, F.tid);
            SEAM(pb + 4);
        }
        if (PHSEL(5) && IN(pb + 5)) {
            ENTER();
            if (!IN(pb + 4)) moe_tables(F, l);
            pg8::MoeOrder<false> S{(const char*)(ws + WS_ACT), (const char*)(ws + WS_WD + (size_t)l * 32 * D * DEXP), DEXP / 2, (size_t)D * DEXP, (unsigned)(uintptr_t)(F.lds + TAB_OFF + 256), 256, nullptr, nullptr};
            pg8::EpiStoreFp8 E{ws + WS_XG, 8.0f * 0.0078125f};
            int kk = DEXP / 2; asm volatile("" : "+s"(kk));
            pg8::gemm_phase<pg8::EpiStoreFp8, pg8::MoeOrder<false>, true, true, 124, 123, true>(F.lds + RING_OFF, kk, S, E, F.tid);
            SEAM(pb + 5);
        }
        if (PHSEL(6) && IN(pb + 6)) { ENTER(); combine_phase(args, F, l, IN(pb + 4)); SEAM(pb + 6); }
    }
#if PROBE
    if (multi) {
        xcd_barrier(bar); STAMP(N_PHASES); __syncthreads();
        const volatile LAS unsigned long long* ts = (const volatile LAS unsigned long long*)(F.lds + LDSCTL_OFF + 2048);
        const float tot = (float)(ts[N_PHASES] - ts[0]); float ta = 0.f, tb = 0.f;
        for (int k = 0; k < N_PHASES; ++k) { const float d = (float)(ts[k + 1] - ts[k]); if ((PROBE_MASK_A >> k) & 1u) ta += d; if ((PROBE_MASK_B >> k) & 1u) tb += d; }
        if ((PROBE_MASK_A >> 28) & 1u) ta += (float)__hip_atomic_load((unsigned long long*)(F.ctl + 12288), RLX_AGENT) * (1.0f / 256.0f);
        if ((PROBE_MASK_A >> 29) & 1u) ta += (float)__hip_atomic_load((unsigned long long*)(F.ctl + 12288) + 8, RLX_AGENT) * (1.0f / 256.0f);
        if ((PROBE_MASK_A >> 30) & 1u) { for (int l = 0; l < DEPTH; ++l) ta += (float)(ts[24 + l] - ts[1 + l * PH_PER_LAYER + 2]); }
        if ((PROBE_MASK_B >> 30) & 1u) { for (int l = 0; l < DEPTH; ++l) tb += (float)(ts[24 + l] - ts[1 + l * PH_PER_LAYER + 2]); }
        const float delta = sqrtf(PROBE_SCALE * ta / tot), big = 2.0f + 48.0f * tb / tot;
        ENTER();
        const int gw = F.vcu * 8 + F.wave, NGW = F.G * 8;
        for (int m = gw; m < M; m += NGW) { GAS f32x4* xr = (GAS f32x4*)(F.out + (size_t)m * D) + F.lane;
#pragma unroll
            for (int j = 0; j < 4; ++j) { f32x4 v = xr[64 * j]; const unsigned idx = (unsigned)m * 1024u + 256u * j + 4u * F.lane; const unsigned hsh = (idx * 2654435761u) >> 13;
                v.x += ((hsh & 1u) ? delta : -delta) * fabsf(v.x); v.y += ((hsh & 2u) ? delta : -delta) * fabsf(v.y); v.z += ((hsh & 4u) ? delta : -delta) * fabsf(v.z); v.w += ((hsh & 8u) ? delta : -delta) * fabsf(v.w);
                if (PROBE_MASK_B != 0u && m == 0 && j == 0 && F.lane == 0) v.x += big;
                xr[64 * j] = v; } }
    }
#endif
#undef IN
#undef SEAM
}

extern "C" void kernel_launch(void* const* d_in, const int* in_sizes, int n_in, void* d_out, int out_size, void* d_ws, size_t ws_size, hipStream_t stream) {
    static int grid = 0;
    if (grid == 0) {
        if (n_in != 23 || in_sizes[0] != M * D || out_size != M * D || ws_size < WS_END) { fprintf(stderr, "kernel_launch: unexpected shapes (n_in %d, in0 %d, out %d, ws %zu < %zu); nothing launched\n", n_in, n_in > 0 ? in_sizes[0] : -1, out_size, ws_size, (size_t)WS_END); grid = -1; return; }
        int dev = 0, cus = 0, per_cu = 0;
        if (hipGetDevice(&dev) != hipSuccess || hipDeviceGetAttribute(&cus, hipDeviceAttributeMultiprocessorCount, dev) != hipSuccess) { grid = -1; return; }
        if (hipFuncSetAttribute((const void*)mk_fwd, hipFuncAttributeMaxDynamicSharedMemorySize, LDS_BYTES) != hipSuccess) { fprintf(stderr, "kernel_launch: hipFuncSetAttribute failed\n"); grid = -1; return; }
        if (hipOccupancyMaxActiveBlocksPerMultiprocessor(&per_cu, (const void*)mk_fwd, 512, LDS_BYTES) != hipSuccess || per_cu < 1) { fprintf(stderr, "kernel_launch: occupancy query reports %d\n", per_cu); }
        (void)hipGetLastError();
        grid = cus;
        if (grid != 256) { fprintf(stderr, "kernel_launch: built for 256 CUs, device has %d\n", grid); grid = -1; return; }
    }
    if (grid < 0) return;
    if (hipMemsetAsync((char*)d_ws + WS_CTL, 0, CTL_ZERO_BYTES, stream) != hipSuccess) return;
    Args a{};
    for (int i = 0; i < 23; ++i) a.in[i] = (const float*)d_in[i];
    a.out = (float*)d_out; a.ws = (unsigned char*)d_ws;
    if (MK_N_LAUNCHES == 1) {
        a.ph_lo = 0; a.ph_hi = N_PHASES;
        hipLaunchKernelGGL(mk_fwd, dim3(grid), dim3(512), LDS_BYTES, stream, a);
    } else {
        for (int p = 0; p < N_PHASES; ++p) { a.ph_lo = p; a.ph_hi = p + 1; hipLaunchKernelGGL(mk_fwd, dim3(grid), dim3(512), LDS_BYTES, stream, a); }
    }
}
```
